# Optimizing an MI355X kernel written in HIP

```python
import math
import jax, jax.numpy as jnp
from jax import lax
import numpy as np

D_MODEL = 1024
BATCH = 4
SEQ = 4096
DEPTH = 4
DEC_BATCH = 128
DEC_SEQ = 4
PAST_LEN = 8192
PAGE_SIZE = 128

HEAD_DIM = 64
R_HEADS = 4
R_WIDTH = R_HEADS * HEAD_DIM
R_DECAY_LORA = 32
R_AAA_LORA = 32
R_GATE_LORA = 64
R_PROJ = 3 * R_WIDTH + R_DECAY_LORA + R_AAA_LORA + R_GATE_LORA
R_SPLITS = [R_WIDTH, 2 * R_WIDTH, 3 * R_WIDTH, 3 * R_WIDTH + R_DECAY_LORA,
            3 * R_WIDTH + R_DECAY_LORA + R_AAA_LORA]
R_GN_EPS = 64e-5
S_Q_HEADS = 8
S_KV_HEADS = 2
S_GROUP = S_Q_HEADS // S_KV_HEADS
S_WIDTH = S_Q_HEADS * HEAD_DIM
S_KV_WIDTH = S_KV_HEADS * HEAD_DIM
S_PROJ = S_WIDTH + 2 * S_KV_WIDTH
WINDOW = 128
ATTN_BLOCK = 128
REL_BUCKETS = 32
REL_MAX_EXACT = 16
REL_MAX_DIST = 128
NEG_INF = -1e30
G_HEADS = 4
G_WIDTH = G_HEADS * HEAD_DIM
G_CONV = 4
G_CHUNK = 64
G_PROJ = 4 * G_WIDTH + 2 * G_HEADS
G_NORM_EPS = 1e-6

MIX_WIDTH = R_WIDTH + S_WIDTH + G_WIDTH
PROJ_DIM = R_PROJ + S_PROJ + G_PROJ
D_FF = 2816
LN_EPS = 1e-5
DN_ALPHA = (2 * DEPTH) ** 0.25
DN_BETA = (8 * DEPTH) ** -0.25

kernel_name = "hymba_rwkv7_swa_gdn_macaron_deepnorm_step"


def layer_norm(x, g, b):
    xf = x.astype(jnp.float32)
    mu = jnp.mean(xf, -1, keepdims=True)
    var = jnp.mean(jnp.square(xf - mu), -1, keepdims=True)
    return ((xf - mu) * lax.rsqrt(var + LN_EPS) * g + b).astype(x.dtype)


def swiglu(x, w_in, w_out):
    gate, up = jnp.split(x @ w_in, 2, axis=-1)
    return (jax.nn.silu(gate) * up) @ w_out


def l2norm(t, eps=1e-6):
    tf = t.astype(jnp.float32)
    return tf * lax.rsqrt(jnp.sum(tf * tf, -1, keepdims=True) + eps)


def rwkv7_scan(r, decay, k, v, kk, a, S0):
    def step(S, inp):
        r_t, w_t, k_t, v_t, kk_t, a_t = inp
        sa = jnp.einsum('bhvk,bhk->bhv', S, -kk_t)
        S = (S * w_t[:, :, None, :] + sa[..., None] * (kk_t * a_t)[:, :, None, :]
             + v_t[..., None] * k_t[:, :, None, :])
        return S, jnp.einsum('bhvk,bhk->bhv', S, r_t)
    xs = tuple(jnp.moveaxis(t, 1, 0) for t in (r, decay, k, v, kk, a))
    S, y = lax.scan(step, S0.astype(jnp.float32), xs)
    return jnp.moveaxis(y, 0, 1), S


def rwkv7_mixer(f, shift_prev, S0, mu, w0, w_up, a0, a_up, g_up, k_k, k_a, r_k, gn_g, gn_b):
    Bn, T, _ = f.shape
    prev = jnp.concatenate([shift_prev[:, None].astype(f.dtype), f[:, :-1]], axis=1)
    fs = f + (prev - f) * mu
    r, k, v, wd, ad, gd = jnp.split(fs, R_SPLITS, axis=-1)
    w = -jax.nn.softplus(-(w0 + jnp.tanh(wd) @ w_up)) - 0.5
    a = jax.nn.sigmoid(a0 + ad @ a_up)
    g = jax.nn.sigmoid(gd) @ g_up
    heads = lambda t: t.reshape(Bn, T, R_HEADS, HEAD_DIM).astype(jnp.float32)
    kk = l2norm(heads(k * k_k))
    k = k * (1 + (a - 1) * k_a)
    r_h, k_h, v_h, a_h = heads(r), heads(k), heads(v), heads(a)
    decay = jnp.exp(-jnp.exp(heads(w)))
    y, S = rwkv7_scan(r_h, decay, k_h, v_h, kk, a_h, S0)
    mean = jnp.mean(y, -1, keepdims=True)
    var = jnp.mean(jnp.square(y - mean), -1, keepdims=True)
    y = ((y - mean) * lax.rsqrt(var + R_GN_EPS)).reshape(Bn, T, R_WIDTH) * gn_g + gn_b
    bonus = jnp.sum(r_h * k_h * r_k, -1, keepdims=True) * v_h
    y = (y + bonus.reshape(Bn, T, R_WIDTH)) * g.astype(jnp.float32)
    return y.astype(f.dtype), S, f[:, -1]


def rel_bias(dist, table):
    n = jnp.maximum(dist, 0)
    nf = jnp.maximum(n, 1).astype(jnp.float32)
    large = REL_MAX_EXACT + (jnp.log(nf / REL_MAX_EXACT) / math.log(REL_MAX_DIST / REL_MAX_EXACT)
                             * (REL_BUCKETS - REL_MAX_EXACT)).astype(jnp.int32)
    bucket = jnp.where(n < REL_MAX_EXACT, n, jnp.minimum(large, REL_BUCKETS - 1))
    return table[bucket].astype(jnp.float32)


def head_bias(dist, table):
    b = jnp.moveaxis(rel_bias(dist, table), -1, 0)
    return b.reshape((S_KV_HEADS, S_GROUP) + dist.shape)


def sink_softmax(logits, mask, sinks):
    logits = jnp.where(mask, logits, NEG_INF)
    m = jnp.maximum(jnp.max(logits, -1, keepdims=True), sinks)
    p = jnp.exp(logits - m)
    return p / (jnp.sum(p, -1, keepdims=True) + jnp.exp(sinks - m))


def swa_prompt(q, k, v, sinks, table):
    Bn, T, _ = q.shape
    nb = T // ATTN_BLOCK
    qb = q.reshape(Bn, nb, ATTN_BLOCK, S_KV_HEADS, S_GROUP, HEAD_DIM)
    kb = k.reshape(Bn, nb, ATTN_BLOCK, S_KV_HEADS, HEAD_DIM)
    vb = v.reshape(Bn, nb, ATTN_BLOCK, S_KV_HEADS, HEAD_DIM)
    band = lambda t: jnp.concatenate(
        [jnp.pad(t, ((0, 0), (1, 0), (0, 0), (0, 0), (0, 0)))[:, :-1], t], axis=2)
    kband, vband = band(kb), band(vb)
    logits = jnp.einsum('bnqhgd,bnkhd->bnhgqk', qb, kband,
                        preferred_element_type=jnp.float32) * HEAD_DIM ** -0.5
    dist = ATTN_BLOCK + jnp.arange(ATTN_BLOCK)[:, None] - jnp.arange(2 * ATTN_BLOCK)[None, :]
    in_window = (dist >= 0) & (dist < WINDOW)
    has_prev = (jnp.arange(nb)[:, None, None] > 0) | (jnp.arange(2 * ATTN_BLOCK)[None, None, :] >= ATTN_BLOCK)
    mask = (in_window[None] & has_prev)[:, None, None]
    s = sinks.astype(jnp.float32).reshape(S_KV_HEADS, S_GROUP, 1, 1)
    probs = sink_softmax(logits + head_bias(dist, table), mask, s)
    out = jnp.einsum('bnhgqk,bnkhd->bnqhgd', probs.astype(v.dtype), vband)
    k_all = k.reshape(Bn, T, S_KV_HEADS, HEAD_DIM)
    v_all = v.reshape(Bn, T, S_KV_HEADS, HEAD_DIM)
    return out.reshape(Bn, T, S_WIDTH), k_all[:, -WINDOW:], v_all[:, -WINDOW:]


def swa_sample(q, k, v, cache_k, cache_v, sinks, table):
    Bn, L, _ = q.shape
    Wc = cache_k.shape[1]
    qh = q.reshape(Bn, L, S_KV_HEADS, S_GROUP, HEAD_DIM)
    keys = jnp.concatenate([cache_k.astype(k.dtype), k.reshape(Bn, L, S_KV_HEADS, HEAD_DIM)], axis=1)
    vals = jnp.concatenate([cache_v.astype(v.dtype), v.reshape(Bn, L, S_KV_HEADS, HEAD_DIM)], axis=1)
    logits = jnp.einsum('bqhgd,bkhd->bhgqk', qh, keys,
                        preferred_element_type=jnp.float32) * HEAD_DIM ** -0.5
    dist = Wc + jnp.arange(L)[:, None] - jnp.arange(Wc + L)[None, :]
    mask = (dist >= 0) & (dist < WINDOW)
    s = sinks.astype(jnp.float32).reshape(S_KV_HEADS, S_GROUP, 1, 1)
    probs = sink_softmax(logits + head_bias(dist, table), mask, s)
    out = jnp.einsum('bhgqk,bkhd->bqhgd', probs.astype(v.dtype), vals)
    return out.reshape(Bn, L, S_WIDTH), keys[:, -Wc:], vals[:, -Wc:]


def gdn_chunked(q, k, v, g, beta, S0):
    Bn, T = q.shape[:2]
    nc = -(-T // G_CHUNK)
    pad = nc * G_CHUNK - T
    def blocks(t):
        t = jnp.pad(t, [(0, 0), (0, pad)] + [(0, 0)] * (t.ndim - 2))
        t = t.reshape((Bn, nc, G_CHUNK) + t.shape[2:])
        return jnp.moveaxis(t, (1, 3), (0, 2))
    qc, kc, vc, gc, bc = (blocks(t) for t in (q, k, v, g, beta))
    G = jnp.cumsum(gc, axis=-1)
    diff = G[..., :, None] - G[..., None, :]
    idx = jnp.arange(G_CHUNK)
    dec_strict = jnp.exp(jnp.where(idx[:, None] > idx[None, :], diff, -jnp.inf))
    dec_causal = jnp.exp(jnp.where(idx[:, None] >= idx[None, :], diff, -jnp.inf))
    kb = kc * bc[..., None]
    A = jnp.eye(G_CHUNK, dtype=jnp.float32) + jnp.einsum('nbhid,nbhjd->nbhij', kb, kc) * dec_strict
    rhs = jnp.concatenate([vc * bc[..., None], kb * jnp.exp(G)[..., None]], axis=-1)
    sol = lax.linalg.triangular_solve(A, rhs, left_side=True, lower=True, unit_diagonal=True)
    u_base, w_state = sol[..., :HEAD_DIM], sol[..., HEAD_DIM:]
    qk = jnp.einsum('nbhid,nbhjd->nbhij', qc, kc) * dec_causal
    q_dec = qc * jnp.exp(G)[..., None]
    k_dec = kc * jnp.exp(G[..., -1:] - G)[..., None]
    chunk_decay = jnp.exp(G[..., -1])[..., None, None]
    def step(S, inp):
        u_b, w_s, qk_n, q_n, k_n, dec_n = inp
        u = u_b - jnp.einsum('bhck,bhkv->bhcv', w_s, S)
        o = jnp.einsum('bhck,bhkv->bhcv', q_n, S) + jnp.einsum('bhij,bhjv->bhiv', qk_n, u)
        S = dec_n * S + jnp.einsum('bhck,bhcv->bhkv', k_n, u)
        return S, o
    S, o = lax.scan(step, S0, (u_base, w_state, qk, q_dec, k_dec, chunk_decay))
    o = jnp.moveaxis(o, (0, 2), (1, 3)).reshape(Bn, nc * G_CHUNK, G_HEADS, HEAD_DIM)[:, :T]
    return o, S


def gdn_mixer(f, conv_buf, S0, conv_w, a_log, dt_bias, norm_g):
    Bn, T, _ = f.shape
    qkv, z, b_logit, a_logit = jnp.split(f, [3 * G_WIDTH, 4 * G_WIDTH, 4 * G_WIDTH + G_HEADS], axis=-1)
    full = jnp.concatenate([conv_buf.astype(f.dtype), qkv], axis=1)
    conv = full[:, 0:T] * conv_w[0]
    for j in range(1, G_CONV):
        conv = conv + full[:, j:j + T] * conv_w[j]
    q, k, v = jnp.split(jax.nn.silu(conv), 3, axis=-1)
    heads = lambda t: t.reshape(Bn, T, G_HEADS, HEAD_DIM)
    q = l2norm(heads(q)) * HEAD_DIM ** -0.5
    k = l2norm(heads(k))
    v = heads(v).astype(jnp.float32)
    beta = jax.nn.sigmoid(b_logit.astype(jnp.float32))
    g = -jnp.exp(a_log.astype(jnp.float32)) * jax.nn.softplus(a_logit.astype(jnp.float32) + dt_bias)
    o, S = gdn_chunked(q, k, v, g, beta, S0.astype(jnp.float32))
    o = o * lax.rsqrt(jnp.mean(o * o, -1, keepdims=True) + G_NORM_EPS) * norm_g
    o = o * jax.nn.silu(heads(z).astype(jnp.float32))
    return o.reshape(Bn, T, G_WIDTH).astype(f.dtype), S, full[:, -(G_CONV - 1):]


def run_trunk(x, rwkv_S, rwkv_shift, swa_k, swa_v, gdn_S, gdn_conv, params, prompt):
    (ffn1_w_in, ffn1_w_out, ln1_g, ln1_b, w_in, rwkv_mu, rwkv_w0, rwkv_w_up, rwkv_a0, rwkv_a_up,
     rwkv_g_up, rwkv_k_k, rwkv_k_a, rwkv_r_k, rwkv_gn_g, rwkv_gn_b, swa_sinks, rel_table,
     gdn_conv_w, gdn_a_log, gdn_dt_bias, gdn_norm_g, w_out, ln2_g, ln2_b,
     ffn2_w_in, ffn2_w_out, ln3_g, ln3_b) = params
    new = [[] for _ in range(6)]
    for l in range(DEPTH):
        x = layer_norm(DN_ALPHA * x + 0.5 * swiglu(x, ffn1_w_in[l], ffn1_w_out[l]), ln1_g[l], ln1_b[l])
        proj = x @ w_in[l]
        f_r, f_s, f_g = jnp.split(proj, [R_PROJ, R_PROJ + S_PROJ], axis=-1)
        y_r, s_r, sh_r = rwkv7_mixer(f_r, rwkv_shift[l], rwkv_S[l], rwkv_mu[l], rwkv_w0[l], rwkv_w_up[l],
                                     rwkv_a0[l], rwkv_a_up[l], rwkv_g_up[l], rwkv_k_k[l], rwkv_k_a[l],
                                     rwkv_r_k[l], rwkv_gn_g[l], rwkv_gn_b[l])
        q, k, v = jnp.split(f_s, [S_WIDTH, S_WIDTH + S_KV_WIDTH], axis=-1)
        if prompt:
            y_s, kc, vc = swa_prompt(q, k, v, swa_sinks[l], rel_table)
        else:
            y_s, kc, vc = swa_sample(q, k, v, swa_k[l], swa_v[l], swa_sinks[l], rel_table)
        y_g, s_g, cb = gdn_mixer(f_g, gdn_conv[l], gdn_S[l], gdn_conv_w[l], gdn_a_log[l],
                                 gdn_dt_bias[l], gdn_norm_g[l])
        mix = jnp.concatenate([y_r, y_s, y_g], axis=-1) @ w_out[l]
        x = layer_norm(DN_ALPHA * x + mix, ln2_g[l], ln2_b[l])
        x = layer_norm(DN_ALPHA * x + 0.5 * swiglu(x, ffn2_w_in[l], ffn2_w_out[l]), ln3_g[l], ln3_b[l])
        for lst, t in zip(new, (s_r, sh_r, kc, vc, s_g, cb)):
            lst.append(t.astype(x.dtype))
    return x, [jnp.stack(lst, axis=0) for lst in new]


def setup_inputs(seed: int = 0) -> dict:
    key = jax.random.key(seed)
    ks = iter(jax.random.split(key, 64))
    nrm = lambda shape, scale: jax.random.normal(next(ks), shape, jnp.float32) * scale
    uni = lambda shape, lo, hi: jax.random.uniform(next(ks), shape, jnp.float32, lo, hi)
    w_buf = min(WINDOW, PAST_LEN)
    dt = jnp.exp(uni((DEPTH, G_HEADS), math.log(1e-3), math.log(1e-1)))
    return {
        "x_prompt": nrm((BATCH, SEQ, D_MODEL), 1.0),
        "x_sample": nrm((DEC_BATCH, DEC_SEQ, D_MODEL), 1.0),
        "state_rwkv": nrm((DEPTH, DEC_BATCH, R_HEADS, HEAD_DIM, HEAD_DIM), 0.3),
        "state_rwkv_shift": nrm((DEPTH, DEC_BATCH, R_PROJ), 1.0),
        "cache_swa_k": nrm((DEPTH, DEC_BATCH, w_buf, S_KV_HEADS, HEAD_DIM), 1.0),
        "cache_swa_v": nrm((DEPTH, DEC_BATCH, w_buf, S_KV_HEADS, HEAD_DIM), 1.0),
        "state_gdn": nrm((DEPTH, DEC_BATCH, G_HEADS, HEAD_DIM, HEAD_DIM), 0.3),
        "state_gdn_conv": nrm((DEPTH, DEC_BATCH, G_CONV - 1, 3 * G_WIDTH), 1.0),
        "ffn1_w_in": nrm((DEPTH, D_MODEL, 2 * D_FF), D_MODEL ** -0.5),
        "ffn1_w_out": nrm((DEPTH, D_FF, D_MODEL), DN_BETA * D_FF ** -0.5),
        "ln1_g": 1.0 + nrm((DEPTH, D_MODEL), 0.02),
        "ln1_b": nrm((DEPTH, D_MODEL), 0.02),
        "w_in": nrm((DEPTH, D_MODEL, PROJ_DIM), D_MODEL ** -0.5),
        "rwkv_mu": uni((DEPTH, R_PROJ), 0.0, 1.0),
        "rwkv_w0": uni((DEPTH, R_WIDTH), -6.0, -1.0),
        "rwkv_w_up": nrm((DEPTH, R_DECAY_LORA, R_WIDTH), 0.5 * R_DECAY_LORA ** -0.5),
        "rwkv_a0": nrm((DEPTH, R_WIDTH), 0.1),
        "rwkv_a_up": nrm((DEPTH, R_AAA_LORA, R_WIDTH), 0.5 * R_AAA_LORA ** -0.5),
        "rwkv_g_up": nrm((DEPTH, R_GATE_LORA, R_WIDTH), R_GATE_LORA ** -0.5),
        "rwkv_k_k": uni((DEPTH, R_WIDTH), 0.7, 1.0),
        "rwkv_k_a": uni((DEPTH, R_WIDTH), 0.8, 1.2),
        "rwkv_r_k": nrm((DEPTH, R_HEADS, HEAD_DIM), 0.1),
        "rwkv_gn_g": 1.0 + nrm((DEPTH, R_WIDTH), 0.02),
        "rwkv_gn_b": nrm((DEPTH, R_WIDTH), 0.02),
        "swa_sinks": nrm((DEPTH, S_Q_HEADS), 1.0),
        "rel_table": nrm((REL_BUCKETS, S_Q_HEADS), 0.5),
        "gdn_conv_w": nrm((DEPTH, G_CONV, 3 * G_WIDTH), G_CONV ** -0.5),
        "gdn_a_log": jnp.log(uni((DEPTH, G_HEADS), 1.0, 16.0)),
        "gdn_dt_bias": dt + jnp.log(-jnp.expm1(-dt)),
        "gdn_norm_g": 1.0 + nrm((DEPTH, HEAD_DIM), 0.02),
        "w_out": nrm((DEPTH, MIX_WIDTH, D_MODEL), DN_BETA * MIX_WIDTH ** -0.5),
        "ln2_g": 1.0 + nrm((DEPTH, D_MODEL), 0.02),
        "ln2_b": nrm((DEPTH, D_MODEL), 0.02),
        "ffn2_w_in": nrm((DEPTH, D_MODEL, 2 * D_FF), D_MODEL ** -0.5),
        "ffn2_w_out": nrm((DEPTH, D_FF, D_MODEL), DN_BETA * D_FF ** -0.5),
        "ln3_g": 1.0 + nrm((DEPTH, D_MODEL), 0.02),
        "ln3_b": nrm((DEPTH, D_MODEL), 0.02),
    }


def reference(x_prompt, x_sample, state_rwkv, state_rwkv_shift, cache_swa_k, cache_swa_v, state_gdn,
              state_gdn_conv, ffn1_w_in, ffn1_w_out, ln1_g, ln1_b, w_in, rwkv_mu, rwkv_w0, rwkv_w_up,
              rwkv_a0, rwkv_a_up, rwkv_g_up, rwkv_k_k, rwkv_k_a, rwkv_r_k, rwkv_gn_g, rwkv_gn_b,
              swa_sinks, rel_table, gdn_conv_w, gdn_a_log, gdn_dt_bias, gdn_norm_g, w_out,
              ln2_g, ln2_b, ffn2_w_in, ffn2_w_out, ln3_g, ln3_b):
    params = (ffn1_w_in, ffn1_w_out, ln1_g, ln1_b, w_in, rwkv_mu, rwkv_w0, rwkv_w_up, rwkv_a0, rwkv_a_up,
              rwkv_g_up, rwkv_k_k, rwkv_k_a, rwkv_r_k, rwkv_gn_g, rwkv_gn_b, swa_sinks, rel_table,
              gdn_conv_w, gdn_a_log, gdn_dt_bias, gdn_norm_g, w_out, ln2_g, ln2_b,
              ffn2_w_in, ffn2_w_out, ln3_g, ln3_b)
    bp = x_prompt.shape[0]
    dtp = x_prompt.dtype
    y_prompt, p_states = run_trunk(
        x_prompt,
        jnp.zeros((DEPTH, bp, R_HEADS, HEAD_DIM, HEAD_DIM), dtp),
        jnp.zeros((DEPTH, bp, R_PROJ), dtp),
        None, None,
        jnp.zeros((DEPTH, bp, G_HEADS, HEAD_DIM, HEAD_DIM), dtp),
        jnp.zeros((DEPTH, bp, G_CONV - 1, 3 * G_WIDTH), dtp),
        params, True)
    y_sample, s_states = run_trunk(x_sample, state_rwkv, state_rwkv_shift, cache_swa_k, cache_swa_v,
                                   state_gdn, state_gdn_conv, params, False)
    p_rwkv, p_rwkv_shift, p_swa_k, p_swa_v, p_gdn, p_gdn_conv = p_states
    s_rwkv, s_rwkv_shift, s_swa_k, s_swa_v, s_gdn, s_gdn_conv = s_states
    return (y_prompt, y_sample, p_rwkv, p_rwkv_shift, p_swa_k, p_swa_v, p_gdn, p_gdn_conv,
            s_rwkv, s_rwkv_shift, s_swa_k, s_swa_v, s_gdn, s_gdn_conv)
```

```cpp
#include <hip/hip_runtime.h>
#include <hip/hip_cooperative_groups.h>
#include <cstdio>
#include <cstdint>
namespace cg = cooperative_groups;
namespace pg8 {
#define PG8_LAS __attribute__((address_space(3)))
typedef unsigned short bf16_t;
typedef short bf16x8 __attribute__((ext_vector_type(8)));
typedef float f32x4 __attribute__((ext_vector_type(4)));
typedef unsigned u32x4 __attribute__((ext_vector_type(4)));
constexpr int BM = 256, BK = 64, HALF = 128, HTB = HALF * BK * 2  , STAGE_BYTES = 8 * HTB, NXCD = 8, WGM = 8;

__host__ __device__ __forceinline__ int lds_byte(int r, int c) { const int st = (r >> 4) * 2 + (c >> 5), rr = r & 15, cc = c & 31, ob = rr * 64 + cc * 2; return st * 1024 + (ob ^ (((ob >> 9) & 1) << 5)); }
__host__ __device__ __forceinline__ void stage_rc(int b, int& R, int& C) { const int st = b / 1024, sb = b % 1024, swz = sb ^ (((sb >> 9) & 1) << 5); R = (st >> 1) * 16 + swz / 64; C = (st & 1) * 32 + (swz % 64) / 2; }
__host__ __device__ __forceinline__ int perm32(int rho) { const int n = rho >> 4, i = rho & 15; return 8 * (i >> 2) + 4 * n + (i & 3); }

struct Unit { int pm, pn; };
struct Gemm { const bf16_t* A; const bf16_t* Bt; int M, N, K, ld; };

struct StaticOrder {
    int nM, nN, nwg, G, c;
    __host__ __device__ void init(int M, int N, int G_, int c_) { nM = M / BM; nN = N / BM; nwg = nM * nN; G = G_; c = c_; }
    __host__ __device__ bool next(int i, Unit& u) const {
        const long L = (long)i * G + c; if (L >= nwg) return false;
        int wgid = (int)L; { const int q = nwg / NXCD, r = nwg % NXCD, xcd = wgid % NXCD, off = wgid / NXCD; wgid = (xcd < r ? xcd * (q + 1) : r * (q + 1) + (xcd - r) * q) + off; }
        const int nig = WGM * nN, gid = wgid / nig, fm = gid * WGM, gsz = (nM - fm) < WGM ? (nM - fm) : WGM;
        u.pm = fm + ((wgid % nig) % gsz); u.pn = (wgid % nig) / gsz; return true;
    }
    __device__ __forceinline__ void a_ready(const Unit&) const {}
    __device__ __forceinline__ void done(const Unit&) const {}
};
struct CountedOrder : StaticOrder {
    const unsigned* ready; unsigned need; unsigned* tmo;
    __device__ __forceinline__ void a_ready(const Unit& u) const {
        if (threadIdx.x < 64) {
            const unsigned long long t0 = __builtin_amdgcn_s_memrealtime(); unsigned polls = 0;
            while ((unsigned)__builtin_amdgcn_readfirstlane(__hip_atomic_load(ready + 64 * u.pm, __ATOMIC_RELAXED, __HIP_MEMORY_SCOPE_AGENT)) < need) {
                if ((++polls & 255u) == 0u && __builtin_amdgcn_readfirstlane(__hip_atomic_load(tmo, __ATOMIC_RELAXED, __HIP_MEMORY_SCOPE_AGENT)) != 0u) break;
                if (__builtin_amdgcn_s_memrealtime() - t0 > 2000000ull) {
                    if (threadIdx.x == 0) { unsigned expect = 0u; __hip_atomic_compare_exchange_strong(tmo + 1, &expect, 0x600u | (unsigned)(u.pm & 0xff), __ATOMIC_RELAXED, __ATOMIC_RELAXED, __HIP_MEMORY_SCOPE_AGENT); __hip_atomic_store(tmo, 1u, __ATOMIC_RELAXED, __HIP_MEMORY_SCOPE_AGENT); }
                    break; }
                __builtin_amdgcn_s_sleep(2); }
            __builtin_amdgcn_fence(__ATOMIC_ACQUIRE, "agent");
            asm volatile("s_waitcnt vmcnt(0)" ::: "memory");
        }
#if !defined(BROKEN_HOOK_NO_BARRIER)
        asm volatile("" ::: "memory"); __builtin_amdgcn_s_barrier(); asm volatile("" ::: "memory");
#endif
    }
};

__device__ __forceinline__ unsigned cvt_pk_bf16(float lo, float hi) { unsigned r; asm volatile("v_cvt_pk_bf16_f32 %0, %1, %2" : "=v"(r) : "v"(lo), "v"(hi)); return r; }
typedef float f32x2 __attribute__((ext_vector_type(2)));
__device__ __forceinline__ f32x2 gelu_pk(f32x2 v) {
    const f32x2 av = __builtin_elementwise_abs(v), d = av * 0.2316418882f + 1.0f;
    f32x2 t; t.x = __builtin_amdgcn_rcpf(d.x); t.y = __builtin_amdgcn_rcpf(d.y);
    f32x2 q = t * 0.5307027145f + (-0.7265760135f); q = q * t + 0.7107068705f; q = q * t + (-0.142248368f); q = q * t + 0.127414796f; q = q * t;
    const f32x2 s = (v * v) * (-0.72134752044f);
    f32x2 e; e.x = __builtin_amdgcn_exp2f(s.x); e.y = __builtin_amdgcn_exp2f(s.y);
    const f32x2 m = v * (q * e), r = v - m;
    f32x2 o; o.x = v.x < 0.f ? m.x : r.x; o.y = v.y < 0.f ? m.y : r.y; return o;
}

struct EpiF32 {
    static constexpr bool PERM = false, AFTER_DRAIN = false;
    float* C; int ldc; const float* bias;
    __device__ __forceinline__ void operator()(const f32x4 (&acc)[2][2][4][2], const Unit& u, int wr, int wc, int fr, int fq) const {
        const int row0 = u.pm * BM + wr * 64 + fr, col0 = u.pn * BM + wc * 32 + 4 * fq;
        f32x4 bv[2][2];
#pragma unroll
        for (int bj = 0; bj < 2; ++bj)
#pragma unroll
            for (int n = 0; n < 2; ++n) bv[bj][n] = bias ? *(const f32x4*)(bias + col0 + bj * HALF + n * 16) : (f32x4){0.f, 0.f, 0.f, 0.f};
#pragma unroll
        for (int ai = 0; ai < 2; ++ai)
#pragma unroll
            for (int m = 0; m < 4; ++m) { float* rowp = C + (size_t)(row0 + ai * HALF + m * 16) * ldc + col0;
#pragma unroll
                for (int bj = 0; bj < 2; ++bj)
#pragma unroll
                    for (int n = 0; n < 2; ++n) *(f32x4*)(rowp + bj * HALF + n * 16) = acc[ai][bj][m][n] + bv[bj][n]; }
    }
};
template <int ACT  > struct EpiBf16 {
    static constexpr bool PERM = true, AFTER_DRAIN = false;
    bf16_t* O; int ldc; const float* bias; int split_cols; size_t split_stride;
    __device__ __forceinline__ void operator()(const f32x4 (&acc)[2][2][4][2], const Unit& u, int wr, int wc, int fr, int fq) const {
        const int row0 = u.pm * BM + wr * 64 + fr; int colt = u.pn * BM; bf16_t* base = O;
        if (split_cols) { const int t = colt / split_cols; base += (size_t)t * split_stride; colt -= t * split_cols; }
        const int col0 = colt + wc * 32 + 8 * fq, bcol0 = u.pn * BM + wc * 32 + 8 * fq;
        f32x4 bv[2][2];
#pragma unroll
        for (int bj = 0; bj < 2; ++bj)
#pragma unroll
            for (int n = 0; n < 2; ++n) bv[bj][n] = bias ? *(const f32x4*)(bias + bcol0 + bj * HALF + 4 * n) : (f32x4){0.f, 0.f, 0.f, 0.f};
#pragma unroll
        for (int ai = 0; ai < 2; ++ai)
#pragma unroll
            for (int m = 0; m < 4; ++m) { bf16_t* rowp = base + (size_t)(row0 + ai * HALF + m * 16) * ldc + col0;
#pragma unroll
                for (int bj = 0; bj < 2; ++bj) { f32x4 v0 = acc[ai][bj][m][0] + bv[bj][0], v1 = acc[ai][bj][m][1] + bv[bj][1];
                    if (ACT == 1) { f32x2 a = gelu_pk((f32x2){v0[0], v0[1]}), b = gelu_pk((f32x2){v0[2], v0[3]}), c = gelu_pk((f32x2){v1[0], v1[1]}), d = gelu_pk((f32x2){v1[2], v1[3]});
                        v0 = (f32x4){a.x, a.y, b.x, b.y}; v1 = (f32x4){c.x, c.y, d.x, d.y}; }
                    if (ACT == 2) {
#pragma unroll
                        for (int j = 0; j < 4; ++j) { v0[j] = 0.5f * v0[j] * (1.0f + erff(v0[j] * 0.70710678f)); v1[j] = 0.5f * v1[j] * (1.0f + erff(v1[j] * 0.70710678f)); } }
                    u32x4 w; w.x = cvt_pk_bf16(v0[0], v0[1]); w.y = cvt_pk_bf16(v0[2], v0[3]); w.z = cvt_pk_bf16(v1[0], v1[1]); w.w = cvt_pk_bf16(v1[2], v1[3]);
                    *(u32x4*)(rowp + bj * HALF) = w; } }
    }
};
template <class Epi, class Sched, bool STAMP = false>
__device__ __forceinline__ void gemm_phase(PG8_LAS unsigned char* lds, const Gemm g, const Sched& S, const Epi& E, unsigned long long* stamps) {
    int tid = threadIdx.x; asm volatile("" : "+v"(tid)); const int wid = __builtin_amdgcn_readfirstlane(tid >> 6), lane = tid & 63, wr = wid >> 2, wc = wid & 3, fr = lane & 15, fq = lane >> 4;
    const int K = g.K, nt = K / BK;
    int ts_lo = 0, ts_hi = 0, nts = 0; const unsigned long long rt_entry = STAMP ? (unsigned long long)wall_clock64() : 0ull;
#define PG8_STAMP() do { if (STAMP && wid == 0 && nts < 64) { const unsigned long long _c = (unsigned long long)clock64(); \
        ts_lo = (lane == nts) ? (int)(unsigned)_c : ts_lo; ts_hi = (lane == nts) ? (int)(unsigned)(_c >> 32) : ts_hi; ++nts; } } while (0)
    PG8_STAMP();
    unsigned voffA[2], voffB[2];
#pragma unroll
    for (int i = 0; i < 2; ++i) { int R, C; stage_rc(tid * 16 + i * 8192, R, C); const int Rb = Epi::PERM ? ((R & ~31) + perm32(R & 31)) : R;
        voffA[i] = (unsigned)(R * g.ld + C) * 2u; voffB[i] = (unsigned)(Rb * g.ld + C) * 2u; }
    const size_t kstep = (size_t)(BK * 2);
    const size_t hstep = (size_t)HALF * g.ld * 2;
    const size_t tstep = 2 * hstep;
    const unsigned ldsw = (unsigned)wid * 1024u;
    const int aoff = lds_byte(wr * 64 + fr, fq * 8), boff = lds_byte(wc * 32 + fr, fq * 8);
#define PG8_SA(b, h) (((b) * 2 + (h)) * HTB)
#define PG8_SB(b, h) ((4 + (b) * 2 + (h)) * HTB)
#define PG8_STAGE(bufoff, gbase, voff) do { _Pragma("unroll") for (int _i = 0; _i < 2; ++_i) \
        __builtin_amdgcn_global_load_lds((const unsigned*)((const char*)(gbase) + (voff)[_i]), (PG8_LAS unsigned*)(lds + (bufoff) + ldsw + _i * 8192), 16, 0, 0); } while (0)
#define PG8_LDA(dst, b, h) do { _Pragma("unroll") for (int m = 0; m < 4; ++m) _Pragma("unroll") for (int k = 0; k < 2; ++k) dst[m][k] = *(const PG8_LAS bf16x8*)(lds + PG8_SA(b, h) + aoff + m * 2048 + k * 1024); } while (0)
#define PG8_LDB(dst, b, h) do { _Pragma("unroll") for (int n = 0; n < 2; ++n) _Pragma("unroll") for (int k = 0; k < 2; ++k) dst[n][k] = *(const PG8_LAS bf16x8*)(lds + PG8_SB(b, h) + boff + n * 2048 + k * 1024); } while (0)
#define PG8_MMA(ai, bj, At, Bt) do { __builtin_amdgcn_s_setprio(1); _Pragma("unroll") for (int m = 0; m < 4; ++m) _Pragma("unroll") for (int n = 0; n < 2; ++n) _Pragma("unroll") for (int k = 0; k < 2; ++k) \
        acc[ai][bj][m][n] = __builtin_amdgcn_mfma_f32_16x16x32_bf16(Bt[n][k], At[m][k], acc[ai][bj][m][n], 0, 0, 0); __builtin_amdgcn_s_setprio(0); } while (0)
#define PG8_WAIT_V(n) asm volatile("s_waitcnt vmcnt(" #n ")" ::: "memory")
#define PG8_WAIT_L(n) asm volatile("s_waitcnt lgkmcnt(" #n ")" ::: "memory")
#define PG8_BAR __builtin_amdgcn_s_barrier()
#define PG8_SCHED __builtin_amdgcn_sched_barrier(0)
    Unit cur, nxt; int ui = 0;
    if (!S.next(0, cur)) return;
    f32x4 acc[2][2][4][2];
#pragma unroll
    for (int a = 0; a < 2; ++a)
#pragma unroll
        for (int b = 0; b < 2; ++b)
#pragma unroll
            for (int m = 0; m < 4; ++m)
#pragma unroll
                for (int n = 0; n < 2; ++n) acc[a][b][m][n] = (f32x4){0.f, 0.f, 0.f, 0.f};
    bf16x8 At[4][2], B0[2][2], B1[2][2];
    const char* cA = (const char*)g.A + (size_t)cur.pm * tstep; const char* cB = (const char*)g.Bt + (size_t)cur.pn * tstep;
    S.a_ready(cur);
    PG8_STAGE(PG8_SB(0, 0), cB, voffB); PG8_STAGE(PG8_SA(0, 0), cA, voffA); PG8_STAGE(PG8_SB(0, 1), cB + hstep, voffB); PG8_STAGE(PG8_SA(0, 1), cA + hstep, voffA);
    if (wr == 1) PG8_BAR;
    PG8_WAIT_V(4); PG8_BAR;
    PG8_STAGE(PG8_SB(1, 0), cB + kstep, voffB); PG8_STAGE(PG8_SA(1, 0), cA + kstep, voffA); PG8_STAGE(PG8_SB(1, 1), cB + hstep + kstep, voffB);
    PG8_WAIT_V(6); PG8_BAR;
    PG8_STAMP();
    for (;;) {
        const bool has_next = S.next(ui + 1, nxt);
        const char* nA = has_next ? (const char*)g.A + (size_t)nxt.pm * tstep : cA; const char* nB = has_next ? (const char*)g.Bt + (size_t)nxt.pn * tstep : cB;
        for (int t = 0; t < nt; t += 2) {
            const bool last = (t == nt - 2);
            const char* a1 = cA + (size_t)(t + 1) * kstep;
            const char* a2 = last ? nA : cA + (size_t)(t + 2) * kstep; const char* b2 = last ? nB : cB + (size_t)(t + 2) * kstep;
            const char* a3 = a2 + kstep; const char* b3 = b2 + kstep;
            if (last && has_next) S.a_ready(nxt);
            PG8_LDB(B0, 0, 0); PG8_SCHED; PG8_LDA(At, 0, 0); PG8_STAGE(PG8_SA(1, 1), a1 + hstep, voffA);
            PG8_WAIT_L(8); PG8_BAR; PG8_WAIT_L(0); PG8_MMA(0, 0, At, B0); PG8_BAR; PG8_SCHED;
            PG8_LDB(B1, 0, 1); PG8_STAGE(PG8_SB(0, 0), b2, voffB);
            PG8_BAR; PG8_WAIT_L(0); PG8_MMA(0, 1, At, B1); PG8_BAR;
            PG8_LDA(At, 0, 1); PG8_STAGE(PG8_SA(0, 0), a2, voffA);
            PG8_BAR; PG8_WAIT_L(0); PG8_MMA(1, 0, At, B0); PG8_BAR; PG8_SCHED;
            PG8_STAGE(PG8_SB(0, 1), b2 + hstep, voffB);
            PG8_WAIT_V(6); PG8_BAR; PG8_MMA(1, 1, At, B1); PG8_BAR;
            PG8_LDB(B0, 1, 0); PG8_SCHED; PG8_LDA(At, 1, 0); PG8_STAGE(PG8_SA(0, 1), a2 + hstep, voffA);
            PG8_WAIT_L(8); PG8_BAR; PG8_WAIT_L(0); PG8_MMA(0, 0, At, B0); PG8_BAR; PG8_SCHED;
            PG8_LDB(B1, 1, 1); PG8_STAGE(PG8_SB(1, 0), b3, voffB);
            PG8_BAR; PG8_WAIT_L(0); PG8_MMA(0, 1, At, B1); PG8_BAR;
            PG8_LDA(At, 1, 1); PG8_STAGE(PG8_SA(1, 0), a3, voffA);
            PG8_BAR; PG8_WAIT_L(0); PG8_MMA(1, 0, At, B0); PG8_BAR; PG8_SCHED;
            PG8_STAGE(PG8_SB(1, 1), b3 + hstep, voffB);
            PG8_WAIT_V(6); PG8_BAR; PG8_MMA(1, 1, At, B1); PG8_BAR;
        }
        PG8_STAMP();
        if constexpr (!Epi::AFTER_DRAIN) { E(acc, cur, wr, wc, fr, fq); S.done(cur); }
        PG8_STAMP();
        if (!has_next) break;
#pragma unroll
        for (int a = 0; a < 2; ++a)
#pragma unroll
            for (int b = 0; b < 2; ++b)
#pragma unroll
                for (int m = 0; m < 4; ++m)
#pragma unroll
                    for (int n = 0; n < 2; ++n) acc[a][b][m][n] = (f32x4){0.f, 0.f, 0.f, 0.f};
        cur = nxt; cA = nA; cB = nB; ++ui;
    }
    PG8_WAIT_V(0);
    if (wr == 0) PG8_BAR;
    PG8_BAR;
    if constexpr (Epi::AFTER_DRAIN) { E.fused(acc, cur, wr, wc, fr, fq, lds, wid, lane); S.done(cur); }
    PG8_STAMP();
    if (STAMP && wid == 0) { stamps[lane] = lane < nts ? (((unsigned long long)(unsigned)ts_hi << 32) | (unsigned)ts_lo) : 0ull;
        if (lane == 62) stamps[62] = rt_entry; if (lane == 63) stamps[63] = (unsigned long long)wall_clock64(); }
#undef PG8_STAMP
#undef PG8_SA
#undef PG8_SB
#undef PG8_STAGE
#undef PG8_LDA
#undef PG8_LDB
#undef PG8_MMA
#undef PG8_WAIT_V
#undef PG8_WAIT_L
#undef PG8_BAR
#undef PG8_SCHED
}
}
#define XB_TMO      128
#define XB_XCNT(j)  (256  + 64 * (j))
#define XB_XSUB(j)  (1280 + 64 * (j))
#define XB_XGEN(j)  (2304 + 64 * (j))
#define XB_TOP      3328
#define XB_TOPGEN   3392
#define XCD_BAR_WORDS 3456
#define XB_SPIN_CAP (1u << 22)
#define XB_LAS __attribute__((address_space(3)))

__device__ __forceinline__ unsigned xb_ld(unsigned* p)              { return __hip_atomic_load(p, __ATOMIC_RELAXED, __HIP_MEMORY_SCOPE_AGENT); }
__device__ __forceinline__ unsigned xb_add(unsigned* p, unsigned v) { return __hip_atomic_fetch_add(p, v, __ATOMIC_RELAXED, __HIP_MEMORY_SCOPE_AGENT); }
__device__ __forceinline__ unsigned xb_xcc_id() { return (unsigned)__builtin_amdgcn_s_getreg((3 << 11) | 20) & 0xFu; }
#define XB_SPIN(cond, bar) do { unsigned _sp = 0; while (cond) { __builtin_amdgcn_s_sleep(1); \
    if ((++_sp & 255u) == 0u) { if (xb_ld(&(bar)[XB_TMO])) break; if (_sp > XB_SPIN_CAP) { atomicAdd(&(bar)[XB_TMO], 1u); break; } } } } while (0)

struct XcdBarrier {
    unsigned* bar; unsigned x;
    volatile XB_LAS unsigned* st;
};

__device__ __forceinline__ XcdBarrier xcd_barrier_post(unsigned* bar, volatile XB_LAS unsigned* st) {
    XcdBarrier b; b.bar = bar; b.x = xb_xcc_id(); b.st = st;
    if (threadIdx.x == 0) (void)xb_add(&bar[XB_XCNT(b.x)], 1u);
    return b;
}
__device__ __forceinline__ void xcd_barrier_complete(unsigned* bar, unsigned x, unsigned& nloc, unsigned& nx) {
    const unsigned G = gridDim.x * gridDim.y * gridDim.z;
    unsigned sum, cnt, mine, sp = 0u;
    for (;;) {
        sum = 0u; cnt = 0u; mine = 0u;
#pragma unroll
        for (unsigned j = 0; j < 16; ++j) { const unsigned c = xb_ld(&bar[XB_XCNT(j)]); sum += c; cnt += (c > 0u) ? 1u : 0u; mine = (j == x) ? c : mine; }
        if (sum == G) break;
        __builtin_amdgcn_s_sleep(1);
        if ((++sp & 255u) == 0u) { if (xb_ld(&bar[XB_TMO])) break; if (sp > XB_SPIN_CAP) { atomicAdd(&bar[XB_TMO], 1u); break; } }
    }
    nloc = mine > 0u ? mine : 1u; nx = cnt > 0u ? cnt : 1u;
}

__device__ __forceinline__ void xcd_barrier(const XcdBarrier& b) {
    asm volatile("s_waitcnt vmcnt(0)" ::: "memory");
    __syncthreads();
    if (threadIdx.x == 0) {
        unsigned* bar = b.bar;
        __builtin_amdgcn_s_waitcnt(0);
        unsigned nloc = b.st[0], nx = b.st[1];
        if (nloc == 0u) { xcd_barrier_complete(bar, b.x, nloc, nx); b.st[0] = nloc; b.st[1] = nx; }
        const unsigned old = xb_add(&bar[XB_XSUB(b.x)], 1u);
        const unsigned gen = old / nloc;
        if (old + 1u == (gen + 1u) * nloc) {
            __builtin_amdgcn_fence(__ATOMIC_RELEASE, "agent");
            asm volatile("s_waitcnt vmcnt(0)" ::: "memory");
            const unsigned og = xb_add(&bar[XB_TOP], 1u);
            const unsigned tg = og / nx;
            if (og + 1u == (tg + 1u) * nx) xb_add(&bar[XB_TOPGEN], 1u);
            else XB_SPIN(xb_ld(&bar[XB_TOPGEN]) == tg, bar);
            __builtin_amdgcn_fence(__ATOMIC_ACQUIRE, "agent");
            xb_add(&bar[XB_XGEN(b.x)], 1u);
            asm volatile("s_waitcnt vmcnt(0)" ::: "memory");
        } else {
            XB_SPIN(xb_ld(&bar[XB_XGEN(b.x)]) == gen, bar);
            __builtin_amdgcn_fence(__ATOMIC_ACQUIRE, "agent");
            asm volatile("s_waitcnt vmcnt(0)" ::: "memory");
        }
    }
    __syncthreads();
}

namespace mk {
using pg8::bf16_t; using pg8::bf16x8; using pg8::f32x4; using pg8::u32x4;
typedef float f32x2 __attribute__((ext_vector_type(2)));
typedef float f32x8 __attribute__((ext_vector_type(8)));
typedef float f32x16 __attribute__((ext_vector_type(16)));
typedef unsigned u32x2 __attribute__((ext_vector_type(2)));
#define MK_CAS __attribute__((address_space(4)))

constexpr int D = 1024, FF = 2816, MP = 16384, MS = 512, M = MP + MS, SEQ = 4096, NPP = 2816, NPROJ = 2696;
constexpr int SO = 896, GO = 1664, DEPTH = 4, PPL = 15, NPH = 1 + PPL * DEPTH;
constexpr int CH_L = 64, NCH = SEQ / CH_L;
constexpr float ALPHA = 1.6817928305074290f;

constexpr size_t SZ_W1A = (size_t)2 * FF * D * 2, SZ_W1B = (size_t)D * FF * 2, SZ_WIN = (size_t)NPP * D * 2, SZ_WOUT = (size_t)D * D * 2;
constexpr size_t WS_W1A = 0, WS_W1B = WS_W1A + SZ_W1A, WS_WIN = WS_W1B + SZ_W1B, WS_WOUT = WS_WIN + SZ_WIN, WS_W2A = WS_WOUT + SZ_WOUT, WS_W2B = WS_W2A + SZ_W1A;
constexpr size_t WS_XF = WS_W2B + SZ_W1B;
constexpr size_t WS_XB = WS_XF + (size_t)M * D * 4;
constexpr size_t WS_PROJ = WS_XB + (size_t)M * D * 2;
constexpr size_t WS_R2 = WS_PROJ + (size_t)M * NPP * 2;
constexpr size_t WS_RWOPS = WS_R2;
constexpr size_t WS_RWC = WS_RWOPS + (size_t)M * 4 * 324 * 4;
constexpr size_t WS_GDOPS = WS_RWC + (size_t)M * 4 * 128 * 4;
constexpr size_t WS_GDC = WS_GDOPS + (size_t)M * 4 * 136 * 4;
constexpr size_t WS_PQ = WS_GDC + (size_t)M * 4 * 128 * 4;
constexpr size_t WS_SST = WS_PQ + (size_t)32 * NCH * 2 * 4096 * 4;
constexpr size_t WS_WL = WS_SST + (size_t)32 * NCH * 4096 * 4;
constexpr size_t WS_BAR = WS_WL + (size_t)DEPTH * 768 * 256 * 2;
constexpr size_t WS_END = WS_BAR + 16384;

constexpr size_t O_YP = 0, O_YS = O_YP + (size_t)MP * D, O_PRW = O_YS + (size_t)MS * D, O_PRS = O_PRW + 4 * 4 * 4 * 4096, O_PSK = O_PRS + 4 * 4 * 896,
                 O_PSV = O_PSK + 4 * 4 * 128 * 128, O_PGD = O_PSV + 4 * 4 * 128 * 128, O_PGC = O_PGD + 4 * 4 * 4 * 4096, O_SRW = O_PGC + 4 * 4 * 3 * 768,
                 O_SRS = O_SRW + (size_t)4 * 128 * 4 * 4096, O_SSK = O_SRS + 4 * 128 * 896, O_SSV = O_SSK + (size_t)4 * 128 * 128 * 128,
                 O_SGD = O_SSV + (size_t)4 * 128 * 128 * 128, O_SGC = O_SGD + (size_t)4 * 128 * 4 * 4096, O_END = O_SGC + 4 * 128 * 3 * 768;

struct Params { const float* in[37]; float* out; unsigned char* ws; int ph_lo, ph_hi; };

struct Frame {
    const float* in[37]; float* out;
    bf16_t *w1a, *w1b, *win, *wout, *w2a, *w2b, *xb, *mix, *proj, *h;
    bf16_t *li, *wl;
    float *xf, *z, *slab, *rwops, *rwc, *gdops, *gdc, *pq, *sst, *dots;
};

__device__ __forceinline__ float bf2f(bf16_t v) { return __uint_as_float(((unsigned)v) << 16); }
__device__ __forceinline__ unsigned pk2(float a, float b) { return pg8::cvt_pk_bf16(a, b); }
__device__ __forceinline__ bf16_t f2bf(float a) { return (bf16_t)(pk2(a, 0.f) & 0xffffu); }
__device__ __forceinline__ float wsum(float v) {
    v += __int_as_float(__builtin_amdgcn_update_dpp(0, __float_as_int(v), 0xB1, 0xf, 0xf, false));
    v += __int_as_float(__builtin_amdgcn_update_dpp(0, __float_as_int(v), 0x4E, 0xf, 0xf, false));
    v += __int_as_float(__builtin_amdgcn_update_dpp(0, __float_as_int(v), 0x141, 0xf, 0xf, false));
    v += __int_as_float(__builtin_amdgcn_update_dpp(0, __float_as_int(v), 0x140, 0xf, 0xf, false));
    v += __int_as_float(__builtin_amdgcn_update_dpp(0, __float_as_int(v), 0x142, 0xa, 0xf, false));
    v += __int_as_float(__builtin_amdgcn_update_dpp(0, __float_as_int(v), 0x143, 0xc, 0xf, false));
    return __int_as_float(__builtin_amdgcn_readlane(__float_as_int(v), 63)); }
__device__ __forceinline__ float sigm(float x) { return __builtin_amdgcn_rcpf(1.f + __expf(-x)); }
__device__ __forceinline__ float silu(float x) { return x * __builtin_amdgcn_rcpf(1.f + __expf(-x)); }
__device__ __forceinline__ float softplus(float x) { return fmaxf(x, 0.f) + log1pf(expf(-fabsf(x))); }
__device__ __forceinline__ int otid() { int t = threadIdx.x; asm volatile("" : "+v"(t)); return t; }
__device__ __forceinline__ int obid() { int b = blockIdx.x; asm volatile("" : "+s"(b)); return b; }
__device__ __forceinline__ const MK_CAS float* launder(const float* p) { unsigned long long a = (unsigned long long)p; asm volatile("" : "+s"(a)); return (const MK_CAS float*)a; }

struct EpiSwiGLU {
    static constexpr bool PERM = true, AFTER_DRAIN = false;
    bf16_t* O;
    __device__ __forceinline__ void operator()(const f32x4 (&acc)[2][2][4][2], const pg8::Unit& u, int wr, int wc, int fr, int fq) const {
        const int row0 = u.pm * 256 + wr * 64 + fr, col0 = u.pn * 128 + wc * 32 + 8 * fq;
#pragma unroll
        for (int ai = 0; ai < 2; ++ai)
#pragma unroll
            for (int m = 0; m < 4; ++m) {
                bf16_t* rowp = O + (size_t)(row0 + ai * 128 + m * 16) * FF + col0;
                const f32x4 g0 = acc[ai][0][m][0], g1 = acc[ai][0][m][1], u0 = acc[ai][1][m][0], u1 = acc[ai][1][m][1];
                u32x4 w;
                w.x = pk2(silu(g0[0]) * u0[0], silu(g0[1]) * u0[1]); w.y = pk2(silu(g0[2]) * u0[2], silu(g0[3]) * u0[3]);
                w.z = pk2(silu(g1[0]) * u1[0], silu(g1[1]) * u1[1]); w.w = pk2(silu(g1[2]) * u1[2], silu(g1[3]) * u1[3]);
                *(u32x4*)rowp = w;
            }
    }
};
struct EpiResid {
    static constexpr bool PERM = false, AFTER_DRAIN = false;
    const float* X; float* Z; float scale;
    __device__ __forceinline__ void operator()(const f32x4 (&acc)[2][2][4][2], const pg8::Unit& u, int wr, int wc, int fr, int fq) const {
        const int row0 = u.pm * 256 + wr * 64 + fr, col0 = u.pn * 256 + wc * 32 + 4 * fq;
#pragma unroll
        for (int ai = 0; ai < 2; ++ai)
#pragma unroll
            for (int m = 0; m < 4; ++m) {
                const size_t off = (size_t)(row0 + ai * 128 + m * 16) * D + col0;
#pragma unroll
                for (int bj = 0; bj < 2; ++bj)
#pragma unroll
                    for (int n = 0; n < 2; ++n) {
                        const f32x4 xv = *(const f32x4*)(X + off + bj * 128 + n * 16);
                        *(f32x4*)(Z + off + bj * 128 + n * 16) = xv * ALPHA + acc[ai][bj][m][n] * scale;
                    }
            }
    }
};

struct EpiSlab {
    static constexpr bool PERM = false, AFTER_DRAIN = false;
    float* Z;
    __device__ __forceinline__ void operator()(const f32x4 (&acc)[2][2][4][2], const pg8::Unit& u, int wr, int wc, int fr, int fq) const {
        const int row0 = u.pm * 256 + wr * 64 + fr, col0 = u.pn * 256 + wc * 32 + 4 * fq;
#pragma unroll
        for (int ai = 0; ai < 2; ++ai)
#pragma unroll
            for (int m = 0; m < 4; ++m) { const size_t off = (size_t)(row0 + ai * 128 + m * 16) * D + col0;
#pragma unroll
                for (int bj = 0; bj < 2; ++bj)
#pragma unroll
                    for (int n = 0; n < 2; ++n) *(f32x4*)(Z + off + bj * 128 + n * 16) = acc[ai][bj][m][n]; }
    }
};
struct OneUnit {
    int pm, pn; bool has;
    __device__ bool next(int i, pg8::Unit& u) const { if (i != 0 || !has) return false; u.pm = pm; u.pn = pn; return true; }
    __device__ __forceinline__ void a_ready(const pg8::Unit&) const {}
    __device__ __forceinline__ void done(const pg8::Unit&) const {}
};

__device__ void conv_jobs(const Frame& F, int l0, int l1, int mask, float* tile, int vb, int nvb) {
    const int tid = otid();
#pragma unroll
    for (int jb = 0; jb < 6; ++jb) {
        const int ly = (jb < 3) ? l1 : l0; if (ly < 0 || ly >= DEPTH || !((mask >> jb) & 1)) continue;
        const float* src; bf16_t* dst; int K, N, Npad, mode = 0;
        if (jb == 0)      { src = F.in[8]  + (size_t)ly * D * 2 * FF; dst = F.w1a;  K = D;  N = 2 * FF; Npad = 2 * FF; mode = 1; }
        else if (jb == 1) { src = F.in[9]  + (size_t)ly * FF * D;     dst = F.w1b;  K = FF; N = D;      Npad = D; }
        else if (jb == 2) { src = F.in[12] + (size_t)ly * D * NPROJ;  dst = F.win;  K = D;  N = NPROJ;  Npad = NPP; }
        else if (jb == 3) { src = F.in[30] + (size_t)ly * D * D;      dst = F.wout; K = D;  N = D;      Npad = D; }
        else if (jb == 4) { src = F.in[33] + (size_t)ly * D * 2 * FF; dst = F.w2a;  K = D;  N = 2 * FF; Npad = 2 * FF; mode = 1; }
        else              { src = F.in[34] + (size_t)ly * FF * D;     dst = F.w2b;  K = FF; N = D;      Npad = D; }
        const int tk = K / 64, tn = Npad / 128, nt = tk * tn;
        for (int t = vb; t < nt; t += nvb) {
            const int k0 = (t % tk) * 64, n0 = (t / tk) * 128;
            float v[16];
#pragma unroll
            for (int i = 0; i < 16; ++i) { const int kk = (tid >> 7) + 4 * i, n = n0 + (tid & 127); v[i] = (n < N) ? src[(size_t)(k0 + kk) * N + n] : 0.f; }
#pragma unroll
            for (int i = 0; i < 16; ++i) tile[((tid >> 7) + 4 * i) * 129 + (tid & 127)] = v[i];
            __syncthreads();
            const int kk2 = (tid & 31) * 2;
#pragma unroll
            for (int i = 0; i < 8; ++i) { const int nn = (tid >> 5) + 16 * i, n = n0 + nn; int nd = n;
                if (mode) { const int half = n / FF, idx = n % FF; nd = (idx >> 7) * 256 + half * 128 + (idx & 127); }
                *(unsigned*)(dst + (size_t)nd * K + k0 + kk2) = pk2(tile[kk2 * 129 + nn], tile[(kk2 + 1) * 129 + nn]); }
            __syncthreads();
        }
    }
}

__device__ __forceinline__ void ln_load(const Frame& F, int row, int lane, int nsl, float scale, f32x4 (&v)[4]) {
#pragma unroll
    for (int i = 0; i < 4; ++i) {
        if (row < MP) v[i] = *(const f32x4*)(F.z + (size_t)row * D + i * 256 + lane * 4);
        else { f32x4 a = {0.f, 0.f, 0.f, 0.f}; for (int q = 0; q < nsl; ++q) a += *(const f32x4*)(F.slab + ((size_t)q * MS + (row - MP)) * D + i * 256 + lane * 4);
               v[i] = *(const f32x4*)(F.xf + (size_t)row * D + i * 256 + lane * 4) * ALPHA + a * scale; } }
}
__device__ __forceinline__ void ln_finish(const Frame& F, int row, int lane, const float* __restrict__ g, const float* __restrict__ b, float* out2, f32x4 (&v)[4]) {
    float s = 0.f;
#pragma unroll
    for (int i = 0; i < 4; ++i) s += (v[i][0] + v[i][1]) + (v[i][2] + v[i][3]);
    const float mean = wsum(s) * (1.f / 1024.f); float q = 0.f;
#pragma unroll
    for (int i = 0; i < 4; ++i) { v[i] = v[i] - mean; q += (v[i][0] * v[i][0] + v[i][1] * v[i][1]) + (v[i][2] * v[i][2] + v[i][3] * v[i][3]); }
    const float rstd = rsqrtf(wsum(q) * (1.f / 1024.f) + 1e-5f);
#pragma unroll
    for (int i = 0; i < 4; ++i) { const int c = i * 256 + lane * 4;
        const f32x4 y = v[i] * rstd * *(const f32x4*)(g + c) + *(const f32x4*)(b + c);
        *(f32x4*)(F.xf + (size_t)row * D + c) = y;
        if (out2) *(f32x4*)(out2 + (size_t)row * D + c) = y;
        u32x2 w; w.x = pk2(y[0], y[1]); w.y = pk2(y[2], y[3]); *(u32x2*)(F.xb + (size_t)row * D + c) = w; }
}
__device__ void ln_phase(const Frame& F, const float* __restrict__ g, const float* __restrict__ b, float* out2, int nsl, float scale) {
    const int tid = otid(), wave = tid >> 6, lane = tid & 63, stride = gridDim.x * 8;
    for (int row = obid() * 8 + wave; row < M; row += 2 * stride) {
        const int row1 = row + stride;
        f32x4 v0[4], v1[4];
        ln_load(F, row, lane, nsl, scale, v0);
        if (row1 < M) ln_load(F, row1, lane, nsl, scale, v1);
        ln_finish(F, row, lane, g, b, out2, v0);
        if (row1 < M) ln_finish(F, row1, lane, g, b, out2, v1);
    }
}

constexpr int RW_STEP = 324, GD_STEP = 136, ROW_REC = 128, NBS = 4;
constexpr int SCAN_BUF_FLOATS = NBS * RW_STEP + NBS * ROW_REC;
constexpr int SCAN_WAVE_FLOATS = 2 * SCAN_BUF_FLOATS + NBS * 64;
#define MK_LAS __attribute__((address_space(3)))
template <bool GDN, bool FULL>
__device__ __forceinline__ void stage_dma(const float* base, const float* rowrec, int nsteps, float* lw, int lane0) {
    constexpr int STEP = GDN ? GD_STEP : RW_STEP, F4 = STEP / 4, NR = GDN ? 3 : 6;
    int lane = lane0; asm volatile("" : "+v"(lane));
    MK_LAS unsigned char* l3 = (MK_LAS unsigned char*)lw;
#pragma unroll
    for (int i = 0; i < NR; ++i) { const int idx = lane + 64 * i, st = idx / F4, wi = idx - st * F4;
        if (FULL ? (idx < NBS * F4) : (st < nsteps)) __builtin_amdgcn_global_load_lds((const unsigned*)(base + (size_t)st * 4 * STEP + wi * 4), (MK_LAS unsigned*)(l3 + i * 1024), 16, 0, 0); }
#pragma unroll
    for (int i = 0; i < 2; ++i) { const int idx = lane + 64 * i, st = idx >> 5, wi = idx & 31;
        if (FULL || st < nsteps) __builtin_amdgcn_global_load_lds((const unsigned*)(rowrec + (size_t)st * 4 * ROW_REC + wi * 4), (MK_LAS unsigned*)(l3 + NBS * RW_STEP * 4 + i * 1024), 16, 0, 0); }
}
#define MK_WAIT_NEXT(GDN) do { if (GDN) asm volatile("s_waitcnt vmcnt(5)" ::: "memory"); else asm volatile("s_waitcnt vmcnt(8)" ::: "memory"); } while (0)

template <bool GDN>
__device__ __forceinline__ void step_pq(f32x2 (&SA)[32], f32x2 (&SB)[32], const float* o, float c) {
    const float* dv = GDN ? o : o + 64;
    f32x2 pa0 = {0.f, 0.f}, pa1 = pa0, pa2 = pa0, pa3 = pa0, qa0 = pa0, qa1 = pa0, qa2 = pa0, qa3 = pa0;
#pragma unroll
    for (int q = 0; q < 16; q += 2) { const f32x4 x = *(const f32x4*)(dv + q * 4), y = *(const f32x4*)(dv + q * 4 + 4);
        const f32x2 x0 = {x[0], x[1]}, x1 = {x[2], x[3]}, y0 = {y[0], y[1]}, y1 = {y[2], y[3]};
        pa0 += SA[2 * q] * x0; pa1 += SA[2 * q + 1] * x1; pa2 += SA[2 * q + 2] * y0; pa3 += SA[2 * q + 3] * y1;
        qa0 += SB[2 * q] * x0; qa1 += SB[2 * q + 1] * x1; qa2 += SB[2 * q + 2] * y0; qa3 += SB[2 * q + 3] * y1; if ((q & 7) == 6) __builtin_amdgcn_sched_barrier(0); }
    const f32x2 pt = (pa0 + pa1) + (pa2 + pa3), qt = (qa0 + qa1) + (qa2 + qa3);
    const float dA = pt.x + pt.y, dB = qt.x + qt.y;
    if (GDN) {
        const float eg = o[128], coef = o[129], uA = coef * dA, uB = coef * dB + c;
        const f32x2 e2 = {eg, eg}, ua2 = {uA, uA}, ub2 = {uB, uB};
#pragma unroll
        for (int q = 0; q < 16; ++q) { const f32x4 k = *(const f32x4*)(o + q * 4); const f32x2 k0 = {k[0], k[1]}, k1 = {k[2], k[3]};
            SA[2 * q] = SA[2 * q] * e2 + ua2 * k0; SA[2 * q + 1] = SA[2 * q + 1] * e2 + ua2 * k1;
            SB[2 * q] = SB[2 * q] * e2 + ub2 * k0; SB[2 * q + 1] = SB[2 * q + 1] * e2 + ub2 * k1; if ((q & 3) == 3) __builtin_amdgcn_sched_barrier(0); }
    } else {
        const f32x2 sa2 = {-dA, -dA}, sb2 = {-dB, -dB}, c2 = {c, c};
#pragma unroll
        for (int q = 0; q < 16; ++q) { const f32x4 w = *(const f32x4*)(o + q * 4), b = *(const f32x4*)(o + 128 + q * 4), k = *(const f32x4*)(o + 192 + q * 4);
            const f32x2 w0 = {w[0], w[1]}, w1 = {w[2], w[3]}, b0 = {b[0], b[1]}, b1 = {b[2], b[3]}, k0 = {k[0], k[1]}, k1 = {k[2], k[3]};
            SA[2 * q] = SA[2 * q] * w0 + sa2 * b0; SA[2 * q + 1] = SA[2 * q + 1] * w1 + sa2 * b1;
            SB[2 * q] = SB[2 * q] * w0 + sb2 * b0 + c2 * k0; SB[2 * q + 1] = SB[2 * q + 1] * w1 + sb2 * b1 + c2 * k1; if ((q & 3) == 3) __builtin_amdgcn_sched_barrier(0); }
    }
}
template <bool GDN>
__device__ __forceinline__ float step_out(f32x2 (&S)[32], const float* o, float c) {
    const float* dv = GDN ? o : o + 64;
    f32x2 a0 = {0.f, 0.f}, a1 = a0, a2 = a0, a3 = a0;
#pragma unroll
    for (int q = 0; q < 16; q += 2) { const f32x4 x = *(const f32x4*)(dv + q * 4), y = *(const f32x4*)(dv + q * 4 + 4);
        a0 += S[2 * q] * (f32x2){x[0], x[1]}; a1 += S[2 * q + 1] * (f32x2){x[2], x[3]}; a2 += S[2 * q + 2] * (f32x2){y[0], y[1]}; a3 += S[2 * q + 3] * (f32x2){y[2], y[3]}; }
    const f32x2 at = (a0 + a1) + (a2 + a3); const float dot = at.x + at.y;
    if (GDN) {
        const float eg = o[128], coef = o[129], u = coef * dot + c; const f32x2 e2 = {eg, eg}, u2 = {u, u};
#pragma unroll
        for (int q = 0; q < 16; ++q) { const f32x4 k = *(const f32x4*)(o + q * 4);
            S[2 * q] = S[2 * q] * e2 + u2 * (f32x2){k[0], k[1]}; S[2 * q + 1] = S[2 * q + 1] * e2 + u2 * (f32x2){k[2], k[3]}; }
    } else {
        const f32x2 sa2 = {-dot, -dot}, c2 = {c, c};
#pragma unroll
        for (int q = 0; q < 16; ++q) { const f32x4 w = *(const f32x4*)(o + q * 4), b = *(const f32x4*)(o + 128 + q * 4), k = *(const f32x4*)(o + 192 + q * 4);
            S[2 * q] = S[2 * q] * (f32x2){w[0], w[1]} + sa2 * (f32x2){b[0], b[1]} + c2 * (f32x2){k[0], k[1]};
            S[2 * q + 1] = S[2 * q + 1] * (f32x2){w[2], w[3]} + sa2 * (f32x2){b[2], b[3]} + c2 * (f32x2){k[2], k[3]}; }
    }
    const float* rv = o + (GDN ? 64 : 256);
    f32x2 y0 = {0.f, 0.f}, y1 = y0, y2 = y0, y3 = y0;
#pragma unroll
    for (int q = 0; q < 16; q += 2) { const f32x4 x = *(const f32x4*)(rv + q * 4), y = *(const f32x4*)(rv + q * 4 + 4);
        y0 += S[2 * q] * (f32x2){x[0], x[1]}; y1 += S[2 * q + 1] * (f32x2){x[2], x[3]}; y2 += S[2 * q + 2] * (f32x2){y[0], y[1]}; y3 += S[2 * q + 3] * (f32x2){y[2], y[3]}; }
    const f32x2 yt = (y0 + y1) + (y2 + y3); return yt.x + yt.y;
}

template <bool GDN>
__device__ __forceinline__ void pass1_item(const Frame& F, int ch, int j, int h, int m0, float* lw, int lane) {
    constexpr int STEP = GDN ? GD_STEP : RW_STEP;
    f32x2 SA[32], SB[32];
#pragma unroll
    for (int i = 0; i < 32; ++i) { SA[i] = (f32x2){(2 * i == lane) ? 1.f : 0.f, (2 * i + 1 == lane) ? 1.f : 0.f}; SB[i] = (f32x2){0.f, 0.f}; }
    const float* ops = (GDN ? F.gdops : F.rwops) + ((size_t)m0 * 4 + h) * STEP;
    const float* rr = (GDN ? F.gdc : F.rwc) + ((size_t)m0 * 4 + h) * ROW_REC;
    stage_dma<GDN, true>(ops, rr, NBS, lw, lane);
    for (int t0 = 0; t0 < CH_L; t0 += NBS) {
        float* cur = lw + ((t0 / NBS) & 1) * SCAN_BUF_FLOATS;
        if (t0 + NBS < CH_L) { stage_dma<GDN, true>(ops + (size_t)(t0 + NBS) * 4 * STEP, rr + (size_t)(t0 + NBS) * 4 * ROW_REC, NBS, lw + (((t0 / NBS) + 1) & 1) * SCAN_BUF_FLOATS, lane); MK_WAIT_NEXT(GDN); }
        else asm volatile("s_waitcnt vmcnt(0)" ::: "memory");
#pragma unroll 1
        for (int e = 0; e < NBS; ++e) step_pq<GDN>(SA, SB, cur + e * STEP, cur[NBS * RW_STEP + e * ROW_REC + lane]);
    }
    float* o = F.pq + ((size_t)(ch * NCH + j) * 2) * 4096 + lane * 64;
#pragma unroll
    for (int i = 0; i < 16; ++i) { *(f32x4*)(o + i * 4) = (f32x4){SA[2 * i].x, SA[2 * i].y, SA[2 * i + 1].x, SA[2 * i + 1].y};
        *(f32x4*)(o + 4096 + i * 4) = (f32x4){SB[2 * i].x, SB[2 * i].y, SB[2 * i + 1].x, SB[2 * i + 1].y}; }
}
__device__ void scan_pass1(const Frame& F, float* ldsf) {
    const int tid = otid(), wave = __builtin_amdgcn_readfirstlane(tid >> 6), lane = tid & 63, G = gridDim.x;
    float* lw = ldsf + wave * SCAN_WAVE_FLOATS;
    for (int it = wave * G + obid(); it < 32 * NCH; it += 8 * G) {
        const int j = it % NCH, c2 = it / NCH, b = c2 & 3, h8 = c2 >> 2, ch = b * 8 + h8, m0 = b * SEQ + j * CH_L;
        if (h8 < 4) pass1_item<false>(F, ch, j, h8, m0, lw, lane); else pass1_item<true>(F, ch, j, h8 - 4, m0, lw, lane);
    }
}

template <bool GDN, bool FULL>
__device__ __forceinline__ void out_item(const Frame& F, int l, f32x2 (&S)[32], int h, int m0, int nsteps, float* lw, int lane) {
    constexpr int STEP = GDN ? GD_STEP : RW_STEP;
    const float* ops = (GDN ? F.gdops : F.rwops) + ((size_t)m0 * 4 + h) * STEP;
    const float* rr = (GDN ? F.gdc : F.rwc) + ((size_t)m0 * 4 + h) * ROW_REC;
    const float gng = GDN ? 0.f : F.in[22][l * 256 + h * 64 + lane], gnb = GDN ? 0.f : F.in[23][l * 256 + h * 64 + lane];
    bf16_t* mixp = F.mix + (size_t)m0 * D + (GDN ? 768 : 0) + h * 64 + lane;
    float* yl = lw + 2 * SCAN_BUF_FLOATS;
    stage_dma<GDN, FULL>(ops, rr, nsteps < NBS ? nsteps : NBS, lw, lane);
    for (int t0 = 0; t0 < nsteps; t0 += NBS) {
        float* cur = lw + ((t0 / NBS) & 1) * SCAN_BUF_FLOATS;
        const int nb = FULL ? NBS : ((nsteps - t0 < NBS) ? nsteps - t0 : NBS);
        if (t0 + NBS < nsteps) { stage_dma<GDN, true>(ops + (size_t)(t0 + NBS) * 4 * STEP, rr + (size_t)(t0 + NBS) * 4 * ROW_REC, NBS, lw + (((t0 / NBS) + 1) & 1) * SCAN_BUF_FLOATS, lane); MK_WAIT_NEXT(GDN); }
        else asm volatile("s_waitcnt vmcnt(0)" ::: "memory");
#pragma unroll 1
        for (int e = 0; e < nb; ++e) yl[e * 64 + lane] = step_out<GDN>(S, cur + e * STEP, cur[NBS * RW_STEP + e * ROW_REC + lane]);
#pragma unroll
        for (int e = 0; e < NBS; ++e) if (e < nb) { const float y = yl[e * 64 + lane]; const float* rw = cur + NBS * RW_STEP + e * ROW_REC; float o;
            if (GDN) { const float ms = wsum(y * y) * (1.f / 64.f); o = y * rsqrtf(ms + 1e-6f) * rw[64 + lane]; }
            else { const float mean = wsum(y) * (1.f / 64.f), d = y - mean, var = wsum(d * d) * (1.f / 64.f);
                   o = (d * rsqrtf(var + 64e-5f) * gng + gnb + cur[e * STEP + 320] * rw[lane]) * rw[64 + lane]; }
            mixp[(size_t)(t0 + e) * D] = f2bf(o); }
    }
}
__device__ void scan_pass3(const Frame& F, int l, float* ldsf) {
    const int tid = otid(), wave = __builtin_amdgcn_readfirstlane(tid >> 6), lane = tid & 63, G = gridDim.x;
    float* lw = ldsf + wave * SCAN_WAVE_FLOATS;
    for (int it = wave * G + obid(); it < 32 * NCH; it += 8 * G) {
        const int j = it % NCH, c2 = it / NCH, b = c2 & 3, h8 = c2 >> 2, ch = b * 8 + h8, m0 = b * SEQ + j * CH_L;
        f32x2 S[32];
        const float* s0 = F.sst + ((size_t)(ch * NCH + j) * 64 + lane) * 64;
#pragma unroll
        for (int i = 0; i < 16; ++i) { const f32x4 v = *(const f32x4*)(s0 + i * 4); S[2 * i] = (f32x2){v[0], v[1]}; S[2 * i + 1] = (f32x2){v[2], v[3]}; }
        if (h8 < 4) out_item<false, true>(F, l, S, h8, m0, CH_L, lw, lane); else out_item<true, true>(F, l, S, h8 - 4, m0, CH_L, lw, lane);
    }
}
__device__ void scan_sample(const Frame& F, int l, int vb, int nvb, float* ldsf) {
    const int tid = otid(), wave = __builtin_amdgcn_readfirstlane(tid >> 6), lane = tid & 63;
    float* lw = ldsf + wave * SCAN_WAVE_FLOATS;
    for (int it = wave * nvb + vb; it < 128 * 8; it += 8 * nvb) {
        const int b = it & 127, h8 = it >> 7, m0 = MP + b * 4;
        f32x2 S[32];
        if (h8 < 4) {
            const size_t so = ((size_t)((l * 128 + b) * 4 + h8) * 64 + lane) * 64;
            const float* s0 = F.in[2] + so;
#pragma unroll
            for (int i = 0; i < 16; ++i) { const f32x4 v = *(const f32x4*)(s0 + i * 4); S[2 * i] = (f32x2){v[0], v[1]}; S[2 * i + 1] = (f32x2){v[2], v[3]}; }
            out_item<false, false>(F, l, S, h8, m0, 4, lw, lane);
            float* o = F.out + O_SRW + so;
#pragma unroll
            for (int i = 0; i < 16; ++i) *(f32x4*)(o + i * 4) = (f32x4){S[2 * i].x, S[2 * i].y, S[2 * i + 1].x, S[2 * i + 1].y};
        } else {
            const int h = h8 - 4;
            const size_t so = (size_t)((l * 128 + b) * 4 + h) * 4096 + lane;
            const float* s0 = F.in[6] + so;
#pragma unroll
            for (int i = 0; i < 32; ++i) S[i] = (f32x2){s0[(2 * i) * 64], s0[(2 * i + 1) * 64]};
            out_item<true, false>(F, l, S, h, m0, 4, lw, lane);
            float* o = F.out + O_SGD + so;
#pragma unroll
            for (int i = 0; i < 32; ++i) { o[(2 * i) * 64] = S[i].x; o[(2 * i + 1) * 64] = S[i].y; }
        }
    }
}

__device__ __forceinline__ float fexp(float x) { return __expf(x); }
__device__ __forceinline__ float fsoftplus(float x) { return (x > 20.f) ? x : __logf(1.f + __expf(x)); }
__device__ __forceinline__ float ftanh(float x) { return 1.f - 2.f * __builtin_amdgcn_rcpf(__expf(2.f * x) + 1.f); }
__device__ void pre_a(const Frame& F, int l) {
    const unsigned gt = (unsigned)obid() * 512u + (unsigned)otid(), gs = gridDim.x * 512u;
    const float* mu = F.in[13] + l * 896;
    for (unsigned i = gt; i < (unsigned)M * 128u; i += gs) { const int m = i >> 7, p = i & 127; unsigned w = 0u;
        if (p < 64) { const int col = 768 + 2 * p;
            const bool samp = m >= MP; const int b = samp ? ((m - MP) >> 2) : (m >> 12), t = samp ? ((m - MP) & 3) : (m & 4095);
            const bf16_t* row = F.proj + (size_t)m * NPP;
            const unsigned fw = *(const unsigned*)(row + col); const float f0 = __uint_as_float(fw << 16), f1 = __uint_as_float(fw & 0xffff0000u);
            float p0 = 0.f, p1 = 0.f;
            if (t > 0) { const unsigned pw = *(const unsigned*)(row + col - NPP); p0 = __uint_as_float(pw << 16); p1 = __uint_as_float(pw & 0xffff0000u); }
            else if (samp) { const float* sp = F.in[3] + (size_t)(l * 128 + b) * 896 + col; p0 = sp[0]; p1 = sp[1]; }
            float a0 = f0 + (p0 - f0) * mu[col], a1 = f1 + (p1 - f1) * mu[col + 1];
            if (p < 16) { a0 = ftanh(a0); a1 = ftanh(a1); } else if (p >= 32) { a0 = sigm(a0); a1 = sigm(a1); }
            w = pk2(a0, a1); }
        ((unsigned*)F.li)[i] = w; }
}
__device__ void conv_lora(const Frame& F) {
    const unsigned gt = (unsigned)obid() * 512u + (unsigned)otid(), gs = gridDim.x * 512u;
    for (unsigned i = gt; i < (unsigned)DEPTH * 768u * 256u; i += gs) { const int k = i & 255, n = (i >> 8) % 768, l = i / (768u * 256u); float v = 0.f;
        if (n < 256) { if (k < 32) v = F.in[15][(l * 32 + k) * 256 + n]; }
        else if (n < 512) { if (k >= 32 && k < 64) v = F.in[17][(l * 32 + k - 32) * 256 + n - 256]; }
        else { if (k >= 64 && k < 128) v = F.in[18][(l * 64 + k - 64) * 256 + n - 512]; }
        F.wl[i] = f2bf(v); }
}
template <bool ST>
__device__ void pre_b(const Frame& F, int l) {
    constexpr int TBB = 3;
    const int tid = otid(), wave = __builtin_amdgcn_readfirstlane(tid >> 6), lane = tid & 63, G = gridDim.x;
    const int per = (M + G - 1) / G, mlo = obid() * per, mhi = (mlo + per < M) ? mlo + per : M;
    if (wave < 4) {
        const int h = wave, c = h * 64 + lane;
        const float* mu = F.in[13] + l * 896;
        const float mu_r = mu[c], mu_k = mu[256 + c], mu_v = mu[512 + c], w0c = F.in[14][l * 256 + c], a0c = F.in[16][l * 256 + c];
        const float kkc = F.in[19][l * 256 + c], kac = F.in[20][l * 256 + c], rkc = F.in[21][l * 256 + c];
        for (int mb = mlo; mb < mhi; mb += TBB) {
            float xr[TBB], xk[TBB], xv[TBB], dw[TBB], da[TBB], dg[TBB];
            const bool fastp = (mb + TBB <= mhi) && (mb + TBB <= MP) && ((mb & 4095) >= 1) && ((mb & 4095) + TBB <= 4096);
            if (fastp) {
#pragma unroll
                for (int e = 0; e < TBB; ++e) { const int m = mb + e;
                    const bf16_t* row = F.proj + (size_t)m * NPP;
                    const float f_r = bf2f(row[c]), f_k = bf2f(row[256 + c]), f_v = bf2f(row[512 + c]);
                    const float p_r = bf2f(row[c - NPP]), p_k = bf2f(row[256 + c - NPP]), p_v = bf2f(row[512 + c - NPP]);
                    xr[e] = f_r + (p_r - f_r) * mu_r; xk[e] = f_k + (p_k - f_k) * mu_k; xv[e] = f_v + (p_v - f_v) * mu_v;
                    const float* dt = F.dots + (size_t)m * 768; dw[e] = dt[c]; da[e] = dt[256 + c]; dg[e] = dt[512 + c]; }
            } else {
#pragma unroll
            for (int e = 0; e < TBB; ++e) { const int m = mb + e; xr[e] = 0.f; xk[e] = 0.f; xv[e] = 0.f; dw[e] = 0.f; da[e] = 0.f; dg[e] = 0.f;
                if (m < mhi) {
                    const bool samp = m >= MP; const int b = samp ? ((m - MP) >> 2) : (m >> 12), t = samp ? ((m - MP) & 3) : (m & 4095);
                    const bf16_t* row = F.proj + (size_t)m * NPP; const float* shp = F.in[3] + (size_t)(l * 128 + b) * 896;
                    const float f_r = bf2f(row[c]), f_k = bf2f(row[256 + c]), f_v = bf2f(row[512 + c]);
                    float p_r = 0.f, p_k = 0.f, p_v = 0.f;
                    if (t > 0) { p_r = bf2f(row[c - NPP]); p_k = bf2f(row[256 + c - NPP]); p_v = bf2f(row[512 + c - NPP]); }
                    else if (samp) { p_r = shp[c]; p_k = shp[256 + c]; p_v = shp[512 + c]; }
                    xr[e] = f_r + (p_r - f_r) * mu_r; xk[e] = f_k + (p_k - f_k) * mu_k; xv[e] = f_v + (p_v - f_v) * mu_v;
                    const float* dt = F.dots + (size_t)m * 768; dw[e] = dt[c]; da[e] = dt[256 + c]; dg[e] = dt[512 + c]; } }
            }
#pragma unroll
            for (int e = 0; e < TBB; ++e) { const int m = mb + e;
                if (m < mhi) {
                    const float r = xr[e], k = xk[e], v = xv[e];
                    const float wl = -fsoftplus(-(w0c + dw[e])) - 0.5f, decay = fexp(-fexp(wl));
                    const float a = sigm(a0c + da[e]);
                    const float kkr = k * kkc, ss = wsum(kkr * kkr), kk = kkr * rsqrtf(ss + 1e-6f);
                    const float k2 = k * (1.f + (a - 1.f) * kac);
                    const float bon = wsum(r * k2 * rkc);
                    float* ops = F.rwops + ((size_t)m * 4 + h) * RW_STEP;
                    if (!ST) { if (decay + kk + k2 + bon == 1234.5f) ops[lane] = 0.f; } else {
                    ops[lane] = decay; ops[64 + lane] = kk; ops[128 + lane] = kk * a; ops[192 + lane] = k2; ops[256 + lane] = r;
                    if (lane < 4) ops[320 + lane] = (lane == 0) ? bon : 0.f;
                    float* rr = F.rwc + ((size_t)m * 4 + h) * ROW_REC; rr[lane] = v; rr[64 + lane] = dg[e]; } } }
        }
    } else {
        const int h = wave - 4, c = h * 64 + lane;
        float cw[4][3];
#pragma unroll
        for (int j = 0; j < 4; ++j)
#pragma unroll
            for (int p = 0; p < 3; ++p) cw[j][p] = F.in[26][(l * 4 + j) * 768 + p * 256 + c];
        const float nalog = -fexp(F.in[27][l * 4 + h]), dtb = F.in[28][l * 4 + h], ng = F.in[29][l * 64 + lane];
        for (int mb = mlo; mb < mhi; mb += TBB) {
            float cv[TBB][3], bl[TBB], al[TBB], zz[TBB];
            const bool fastp = (mb + TBB <= mhi) && (mb + TBB <= MP) && ((mb & 4095) >= 3) && ((mb & 4095) + TBB <= 4096);
            if (fastp) {
#pragma unroll
                for (int e = 0; e < TBB; ++e) { const int m = mb + e;
                    const bf16_t* row = F.proj + (size_t)m * NPP;
#pragma unroll
                    for (int p = 0; p < 3; ++p) { const int chn = p * 256 + c; float acc = 0.f;
#pragma unroll
                        for (int j = 0; j < 4; ++j) acc += bf2f(row[GO + chn - (3 - j) * NPP]) * cw[j][p];
                        cv[e][p] = acc; }
                    bl[e] = bf2f(row[GO + 1024 + h]); al[e] = bf2f(row[GO + 1028 + h]); zz[e] = bf2f(row[GO + 768 + c]); }
            } else {
#pragma unroll
            for (int e = 0; e < TBB; ++e) { const int m = mb + e; cv[e][0] = 0.f; cv[e][1] = 0.f; cv[e][2] = 0.f; bl[e] = 0.f; al[e] = 0.f; zz[e] = 0.f;
                if (m < mhi) {
                    const bool samp = m >= MP; const int b = samp ? ((m - MP) >> 2) : (m >> 12), t = samp ? ((m - MP) & 3) : (m & 4095);
                    const bf16_t* row = F.proj + (size_t)m * NPP;
#pragma unroll
                    for (int p = 0; p < 3; ++p) { const int chn = p * 256 + c; float acc = 0.f;
#pragma unroll
                        for (int j = 0; j < 4; ++j) { const int back = 3 - j; float x;
                            if (t - back >= 0) x = bf2f(row[GO + chn - back * NPP]);
                            else x = samp ? F.in[7][((size_t)(l * 128 + b) * 3 + (t - back + 3)) * 768 + chn] : 0.f;
                            acc += x * cw[j][p]; }
                        cv[e][p] = acc; }
                    bl[e] = bf2f(row[GO + 1024 + h]); al[e] = bf2f(row[GO + 1028 + h]); zz[e] = bf2f(row[GO + 768 + c]); } }
            }
#pragma unroll
            for (int e = 0; e < TBB; ++e) { const int m = mb + e;
                if (m < mhi) {
                    const float q = silu(cv[e][0]), k = silu(cv[e][1]), v = silu(cv[e][2]);
                    const float qs = wsum(q * q), ks = wsum(k * k);
                    const float qn = q * rsqrtf(qs + 1e-6f) * 0.125f, kn = k * rsqrtf(ks + 1e-6f);
                    const float beta = sigm(bl[e]), gg = nalog * fsoftplus(al[e] + dtb), eg = fexp(gg);
                    float* gops = F.gdops + ((size_t)m * 4 + h) * GD_STEP;
                    if (!ST) { if (kn + qn + eg + v == 1234.5f) gops[lane] = 0.f; } else {
                    gops[lane] = kn; gops[64 + lane] = qn;
                    if (lane < 8) gops[128 + lane] = (lane == 0) ? eg : ((lane == 1) ? -beta * eg : 0.f);
                    float* rr = F.gdc + ((size_t)m * 4 + h) * ROW_REC; rr[lane] = beta * v; rr[64 + lane] = ng * silu(zz[e]); } } }
        }
    }
}

__device__ __forceinline__ void split8(const f32x4 x0, const f32x4 x1, bf16x8& hi, bf16x8& lo) {
    u32x4 h, l; float r[8] = {x0[0], x0[1], x0[2], x0[3], x1[0], x1[1], x1[2], x1[3]};
    unsigned hw[4], lw[4];
#pragma unroll
    for (int i = 0; i < 4; ++i) { hw[i] = pk2(r[2 * i], r[2 * i + 1]);
        const float d0 = r[2 * i] - __uint_as_float(hw[i] << 16), d1 = r[2 * i + 1] - __uint_as_float(hw[i] & 0xffff0000u); lw[i] = pk2(d0, d1); }
    h = (u32x4){hw[0], hw[1], hw[2], hw[3]}; l = (u32x4){lw[0], lw[1], lw[2], lw[3]};
    hi = __builtin_bit_cast(bf16x8, h); lo = __builtin_bit_cast(bf16x8, l);
}
__device__ __forceinline__ void chain_store_p(bf16_t* Pt, int tid, const f32x4 (&pn)[2]) {
#pragma unroll
    for (int e = 0; e < 2; ++e) { const int idx = tid + 512 * e, i = idx >> 4, kc0 = (idx & 15) * 4;
#pragma unroll
        for (int c = 0; c < 4; ++c) { const float x = pn[e][c]; const unsigned hw = pk2(x, 0.f) & 0xffffu; const float d = x - __uint_as_float(hw << 16);
            Pt[(kc0 + c) * 72 + i] = (bf16_t)hw; Pt[4608 + (kc0 + c) * 72 + i] = f2bf(d); } }
}
__device__ void chain_prop(const Frame& F, int l, int ch, float* lds) {
    const int tid = otid(), wave = tid >> 6, lane = tid & 63, fr = lane & 15, gq = lane >> 4, b = ch >> 3, h8 = ch & 7;
    float* Sl = lds; bf16_t* Pb = (bf16_t*)(lds + 64 * 68);
    const int tr = wave >> 1, tc0 = (wave & 1) * 2;
    for (int i = tid; i < 64 * 68; i += 512) Sl[i] = 0.f;
    { float* s0 = F.sst + (size_t)(ch * NCH) * 4096; for (int i = tid; i < 1024; i += 512) *(f32x4*)(s0 + i * 4) = (f32x4){0.f, 0.f, 0.f, 0.f}; }
    { const float* pg = F.pq + (size_t)(ch * NCH) * 2 * 4096; f32x4 pn[2];
#pragma unroll
      for (int e = 0; e < 2; ++e) pn[e] = *(const f32x4*)(pg + (tid + 512 * e) * 4);
      chain_store_p(Pb, tid, pn); }
    f32x4 qn[2];
    { const float* Qg = F.pq + ((size_t)(ch * NCH) * 2 + 1) * 4096;
#pragma unroll
      for (int tt = 0; tt < 2; ++tt)
#pragma unroll
        for (int r = 0; r < 4; ++r) qn[tt][r] = Qg[(16 * tr + 4 * gq + r) * 64 + 16 * (tc0 + tt) + fr]; }
    __syncthreads();
    for (int j = 0; j < NCH; ++j) {
        const bf16_t* Pj = Pb + (j & 1) * 9216;
        f32x4 pn[2] = {{0.f, 0.f, 0.f, 0.f}, {0.f, 0.f, 0.f, 0.f}};
        f32x4 acc[2] = {qn[0], qn[1]};
        if (j + 1 < NCH) { const float* pg = F.pq + ((size_t)(ch * NCH + j + 1) * 2) * 4096;
#pragma unroll
            for (int e = 0; e < 2; ++e) pn[e] = *(const f32x4*)(pg + (tid + 512 * e) * 4);
            const float* Qg = pg + 4096;
#pragma unroll
            for (int tt = 0; tt < 2; ++tt)
#pragma unroll
                for (int r = 0; r < 4; ++r) qn[tt][r] = Qg[(16 * tr + 4 * gq + r) * 64 + 16 * (tc0 + tt) + fr]; }
#pragma unroll
        for (int ks = 0; ks < 2; ++ks) {
            const float* ar = Sl + (16 * tr + fr) * 68 + ks * 32 + gq * 8;
            bf16x8 ahi, alo; split8(*(const f32x4*)ar, *(const f32x4*)(ar + 4), ahi, alo);
#pragma unroll
            for (int tt = 0; tt < 2; ++tt) { const bf16_t* br = Pj + (16 * (tc0 + tt) + fr) * 72 + ks * 32 + gq * 8;
                const bf16x8 bhi = *(const bf16x8*)br, blo = *(const bf16x8*)(br + 4608);
                acc[tt] = __builtin_amdgcn_mfma_f32_16x16x32_bf16(ahi, bhi, acc[tt], 0, 0, 0);
                acc[tt] = __builtin_amdgcn_mfma_f32_16x16x32_bf16(alo, bhi, acc[tt], 0, 0, 0);
                acc[tt] = __builtin_amdgcn_mfma_f32_16x16x32_bf16(ahi, blo, acc[tt], 0, 0, 0); }
        }
        if (j + 1 < NCH) chain_store_p(Pb + ((j + 1) & 1) * 9216, tid, pn);
        __syncthreads();
#pragma unroll
        for (int tt = 0; tt < 2; ++tt)
#pragma unroll
            for (int r = 0; r < 4; ++r) { const int v = 16 * tr + 4 * gq + r, k = 16 * (tc0 + tt) + fr; const float x = acc[tt][r];
                Sl[v * 68 + k] = x;
                if (j + 1 < NCH) F.sst[(size_t)(ch * NCH + j + 1) * 4096 + v * 64 + k] = x;
                else if (h8 < 4) F.out[O_PRW + (size_t)((l * 4 + b) * 4 + h8) * 4096 + v * 64 + k] = x;
                else F.out[O_PGD + (size_t)((l * 4 + b) * 4 + (h8 - 4)) * 4096 + k * 64 + v] = x; }
        __syncthreads();
    }
}

__device__ void copy_states(const Frame& F, int l) {
    const unsigned gt = (unsigned)obid() * 512u + (unsigned)otid(), gs = gridDim.x * 512u;
    const bf16_t* P = F.proj;
    for (unsigned i = gt; i < 4u * 896u; i += gs) { const unsigned b = i / 896u, c = i - b * 896u; F.out[O_PRS + (size_t)(l * 4 + b) * 896 + c] = bf2f(P[(size_t)(b * SEQ + SEQ - 1) * NPP + c]); }
    for (unsigned i = gt; i < 128u * 896u; i += gs) { const unsigned b = i / 896u, c = i - b * 896u; F.out[O_SRS + (size_t)(l * 128 + b) * 896 + c] = bf2f(P[(size_t)(MP + 4 * b + 3) * NPP + c]); }
    for (unsigned i = gt; i < 4u * 2304u; i += gs) { const unsigned b = i / 2304u, r = i - b * 2304u, j = r / 768u, c = r - j * 768u; F.out[O_PGC + (size_t)(l * 4 + b) * 2304 + r] = bf2f(P[(size_t)(b * SEQ + SEQ - 3 + j) * NPP + GO + c]); }
    for (unsigned i = gt; i < 128u * 2304u; i += gs) { const unsigned b = i / 2304u, r = i - b * 2304u, j = r / 768u, c = r - j * 768u; F.out[O_SGC + (size_t)(l * 128 + b) * 2304 + r] = bf2f(P[(size_t)(MP + 4 * b + 1 + j) * NPP + GO + c]); }
    for (unsigned i = gt; i < 4u * 128u * 128u; i += gs) { const unsigned c = i & 127u, w = (i >> 7) & 127u, b = i >> 14; const size_t r = (size_t)(b * SEQ + SEQ - 128 + w) * NPP + SO;
        F.out[O_PSK + (size_t)(l * 4 + b) * 16384 + w * 128 + c] = bf2f(P[r + 512 + c]); F.out[O_PSV + (size_t)(l * 4 + b) * 16384 + w * 128 + c] = bf2f(P[r + 640 + c]); }
    for (unsigned i = gt; i < 128u * 128u * 32u; i += gs) { const unsigned c4 = i & 31u, w = (i >> 5) & 127u, b = i >> 12; f32x4 kx, vx;
        if (w < 124u) { const size_t s = ((size_t)(l * 128 + b) * 128 + w + 4) * 128 + c4 * 4; kx = *(const f32x4*)(F.in[4] + s); vx = *(const f32x4*)(F.in[5] + s); }
        else { const bf16_t* r = P + (size_t)(MP + 4 * b + w - 124) * NPP + SO + 512 + c4 * 4; const u32x2 kw = *(const u32x2*)r, vw = *(const u32x2*)(r + 128);
            kx = (f32x4){__uint_as_float(kw.x << 16), __uint_as_float(kw.x & 0xffff0000u), __uint_as_float(kw.y << 16), __uint_as_float(kw.y & 0xffff0000u)};
            vx = (f32x4){__uint_as_float(vw.x << 16), __uint_as_float(vw.x & 0xffff0000u), __uint_as_float(vw.y << 16), __uint_as_float(vw.y & 0xffff0000u)}; }
        const size_t o = (size_t)(l * 128 + b) * 16384 + w * 128 + c4 * 4;
        *(f32x4*)(F.out + O_SSK + o) = kx; *(f32x4*)(F.out + O_SSV + o) = vx; }
}

constexpr int SWA_KP = 72, SWA_VP = 280, SWA_KS_BYTES = 272 * SWA_KP * 2, SWA_VT_BYTES = 64 * SWA_VP * 2;
__device__ const unsigned char REL_BUCKET[128] = {0,1,2,3,4,5,6,7,8,9,10,11,12,13,14,15,16,16,16,17,17,18,18,18,19,19,19,20,20,20,20,21,21,21,21,22,22,22,22,22,23,23,23,23,23,23,24,24,24,24,24,24,25,25,25,25,25,25,25,26,26,26,26,26,26,26,26,27,27,27,27,27,27,27,27,27,27,28,28,28,28,28,28,28,28,28,28,29,29,29,29,29,29,29,29,29,29,29,29,30,30,30,30,30,30,30,30,30,30,30,30,30,30,31,31,31,31,31,31,31,31,31,31,31,31,31,31,31};

__device__ __forceinline__ void swa_core(const bf16_t* Ks, const bf16_t* Vt, const float* biasl, int t0, bf16x8 qf0, bf16x8 qf1, int qpos, int g, int minkey, float sink, f32x4 (&o)[4]) {
    const int lane = otid() & 63, fr = lane & 15, gq = lane >> 4;
    f32x4 s[10];
#pragma unroll
    for (int ti = 0; ti < 10; ++ti) {
        const bf16_t* kr = Ks + ((t0 + ti) * 16 + fr) * SWA_KP + gq * 8;
        const bf16x8 a0 = *(const bf16x8*)kr, a1 = *(const bf16x8*)(kr + 32);
        f32x4 acc = {0.f, 0.f, 0.f, 0.f};
        acc = __builtin_amdgcn_mfma_f32_16x16x32_bf16(a0, qf0, acc, 0, 0, 0);
        acc = __builtin_amdgcn_mfma_f32_16x16x32_bf16(a1, qf1, acc, 0, 0, 0);
        s[ti] = acc;
    }
    float mx = sink;
#pragma unroll
    for (int ti = 0; ti < 10; ++ti)
#pragma unroll
        for (int j = 0; j < 4; ++j) { const int kl = (t0 + ti) * 16 + gq * 4 + j, dist = qpos - kl; const bool ok = (dist >= 0) && (dist < 128) && (kl >= minkey);
            const float v = ok ? s[ti][j] * 0.125f + biasl[(ok ? dist : 0) * 4 + g] : -INFINITY; s[ti][j] = v; mx = fmaxf(mx, v); }
    mx = fmaxf(mx, __shfl_xor(mx, 16)); mx = fmaxf(mx, __shfl_xor(mx, 32));
    float lsum = 0.f;
#pragma unroll
    for (int ti = 0; ti < 10; ++ti)
#pragma unroll
        for (int j = 0; j < 4; ++j) { const float p = __expf(s[ti][j] - mx); s[ti][j] = p; lsum += p; }
    lsum += __shfl_xor(lsum, 16); lsum += __shfl_xor(lsum, 32); lsum += __expf(sink - mx);
    const float inv = 1.f / lsum;
#pragma unroll
    for (int dt = 0; dt < 4; ++dt) o[dt] = (f32x4){0.f, 0.f, 0.f, 0.f};
#pragma unroll
    for (int st = 0; st < 5; ++st) {
        u32x4 pw; pw.x = pk2(s[2 * st][0], s[2 * st][1]); pw.y = pk2(s[2 * st][2], s[2 * st][3]); pw.z = pk2(s[2 * st + 1][0], s[2 * st + 1][1]); pw.w = pk2(s[2 * st + 1][2], s[2 * st + 1][3]);
        const bf16x8 pb = __builtin_bit_cast(bf16x8, pw);
        const int k0 = (t0 + 2 * st) * 16 + gq * 4, k1 = k0 + 16;
#pragma unroll
        for (int dt = 0; dt < 4; ++dt) {
            const bf16_t* vr = Vt + (dt * 16 + fr) * SWA_VP;
            const u32x2 lo = *(const u32x2*)(vr + k0), hi = *(const u32x2*)(vr + k1);
            const u32x4 aw = {lo.x, lo.y, hi.x, hi.y};
            o[dt] = __builtin_amdgcn_mfma_f32_16x16x32_bf16(__builtin_bit_cast(bf16x8, aw), pb, o[dt], 0, 0, 0);
        }
    }
#pragma unroll
    for (int dt = 0; dt < 4; ++dt) o[dt] = o[dt] * inv;
}

__device__ __forceinline__ void swa_bias_fill(const Frame& F, int kvh, float* biasl) {
    const int tid = otid();
    { const int dist = tid >> 2, g = tid & 3; biasl[tid] = F.in[25][REL_BUCKET[dist] * 8 + kvh * 4 + g]; }
}

__device__ void swa_prompt_item(const Frame& F, int l, int item, unsigned char* lds) {
    bf16_t* Ks = (bf16_t*)lds; bf16_t* Vt = (bf16_t*)(lds + SWA_KS_BYTES); float* biasl = (float*)(lds + SWA_KS_BYTES + SWA_VT_BYTES);
    const int tid = otid(), wave = tid >> 6, lane = tid & 63, fr = lane & 15, gq = lane >> 4;
    const int kvh = item & 1, qt = (item >> 1) & 31, b = item >> 6;
    const int T0 = qt * 128 - 144;
    __syncthreads();
    swa_bias_fill(F, kvh, biasl);
    for (int e = tid; e < 272 * 8; e += 512) { const int i = e >> 3, d8 = e & 7, tk = T0 + i;
        u32x4 kw = {0u, 0u, 0u, 0u}, vw = {0u, 0u, 0u, 0u};
        if (tk >= 0) { const bf16_t* r = F.proj + (size_t)(b * SEQ + tk) * NPP + SO + 512 + kvh * 64 + d8 * 8; kw = *(const u32x4*)r; vw = *(const u32x4*)(r + 128); }
        *(u32x4*)(Ks + i * SWA_KP + d8 * 8) = kw;
        bf16_t* vd = Vt + (d8 * 8) * SWA_VP + i;
        vd[0] = (bf16_t)(vw.x & 0xffff); vd[SWA_VP] = (bf16_t)(vw.x >> 16); vd[2 * SWA_VP] = (bf16_t)(vw.y & 0xffff); vd[3 * SWA_VP] = (bf16_t)(vw.y >> 16);
        vd[4 * SWA_VP] = (bf16_t)(vw.z & 0xffff); vd[5 * SWA_VP] = (bf16_t)(vw.z >> 16); vd[6 * SWA_VP] = (bf16_t)(vw.w & 0xffff); vd[7 * SWA_VP] = (bf16_t)(vw.w >> 16); }
    __syncthreads();
    const int g = wave & 3, half = wave >> 2, head = kvh * 4 + g;
    const float sink = F.in[24][l * 8 + head];
    int minkey = 144 - qt * 128; if (minkey < 0) minkey = 0;
    for (int st = 0; st < 4; ++st) {
        const int ql = half * 64 + st * 16;
        const int m = b * SEQ + qt * 128 + ql + fr;
        const bf16_t* qr = F.proj + (size_t)m * NPP + SO + head * 64 + gq * 8;
        const bf16x8 qf0 = *(const bf16x8*)qr, qf1 = *(const bf16x8*)(qr + 32);
        f32x4 o[4];
        swa_core(Ks, Vt, biasl, half * 4 + st, qf0, qf1, 144 + ql + fr, g, minkey, sink, o);
        bf16_t* op = F.mix + (size_t)m * D + 256 + head * 64 + gq * 4;
#pragma unroll
        for (int dt = 0; dt < 4; ++dt) { u32x2 w; w.x = pk2(o[dt][0], o[dt][1]); w.y = pk2(o[dt][2], o[dt][3]); *(u32x2*)(op + dt * 16) = w; }
    }
}

__device__ void swa_sample_item(const Frame& F, int l, int item, unsigned char* lds) {
    bf16_t* Ks = (bf16_t*)lds; bf16_t* Vt = (bf16_t*)(lds + SWA_KS_BYTES); float* biasl = (float*)(lds + SWA_KS_BYTES + SWA_VT_BYTES);
    const int tid = otid(), wave = tid >> 6, lane = tid & 63, fr = lane & 15, gq = lane >> 4;
    const int kvh = item & 1, b = item >> 1;
    __syncthreads();
    swa_bias_fill(F, kvh, biasl);
    for (int e = tid; e < 160 * 64; e += 512) { const int i = e >> 6, d = e & 63; float kx = 0.f, vx = 0.f;
        if (i < 128) { const size_t s = ((size_t)(l * 128 + b) * 128 + i) * 128 + kvh * 64 + d; kx = F.in[4][s]; vx = F.in[5][s]; }
        else if (i < 132) { const bf16_t* r = F.proj + (size_t)(MP + 4 * b + i - 128) * NPP + SO + 512 + kvh * 64 + d; kx = bf2f(r[0]); vx = bf2f(r[128]); }
        Ks[i * SWA_KP + d] = f2bf(kx); Vt[d * SWA_VP + i] = f2bf(vx); }
    __syncthreads();
    if (wave == 0) {
        const int ti = fr >> 2, g = fr & 3, head = kvh * 4 + g, m = MP + 4 * b + ti;
        const bf16_t* qr = F.proj + (size_t)m * NPP + SO + head * 64 + gq * 8;
        const bf16x8 qf0 = *(const bf16x8*)qr, qf1 = *(const bf16x8*)(qr + 32);
        f32x4 o[4];
        swa_core(Ks, Vt, biasl, 0, qf0, qf1, 128 + ti, g, 0, F.in[24][l * 8 + head], o);
        bf16_t* op = F.mix + (size_t)m * D + 256 + head * 64 + gq * 4;
#pragma unroll
        for (int dt = 0; dt < 4; ++dt) { u32x2 w; w.x = pk2(o[dt][0], o[dt][1]); w.y = pk2(o[dt][2], o[dt][3]); *(u32x2*)(op + dt * 16) = w; }
    }
}

constexpr int LDS_BYTES = pg8::STAGE_BYTES + 16;

__global__ void __launch_bounds__(512, 2) fwd_megakernel(Params p) {
    extern __shared__ __attribute__((aligned(16))) unsigned char lds[];
    cg::grid_group grid = cg::this_grid();
    PG8_LAS unsigned char* ldsl = (PG8_LAS unsigned char*)lds;
    float* ldsf = (float*)lds;
    const int G = gridDim.x;
    if (threadIdx.x < 4) ((unsigned*)(lds + pg8::STAGE_BYTES))[threadIdx.x] = 0u;
    __syncthreads();
    (void)xcd_barrier_post((unsigned*)(p.ws + WS_BAR), (volatile XB_LAS unsigned*)(lds + pg8::STAGE_BYTES));

    for (int ph = p.ph_lo; ph < p.ph_hi; ++ph) {
        Frame F;
        size_t wz = 0; asm volatile("" : "+s"(wz));
#pragma unroll
        for (int k = 0; k < 37; ++k) F.in[k] = p.in[k];
        F.out = p.out;
        unsigned char* ws = p.ws + wz;
        F.w1a = (bf16_t*)(ws + WS_W1A); F.w1b = (bf16_t*)(ws + WS_W1B); F.win = (bf16_t*)(ws + WS_WIN); F.wout = (bf16_t*)(ws + WS_WOUT); F.w2a = (bf16_t*)(ws + WS_W2A); F.w2b = (bf16_t*)(ws + WS_W2B);
        F.xf = (float*)(ws + WS_XF); F.xb = (bf16_t*)(ws + WS_XB); F.mix = F.xb; F.proj = (bf16_t*)(ws + WS_PROJ); F.h = F.proj; F.z = (float*)(ws + WS_R2); F.slab = (float*)(ws + WS_R2 + (size_t)M * D * 4);
        F.rwops = (float*)(ws + WS_RWOPS); F.rwc = (float*)(ws + WS_RWC); F.gdops = (float*)(ws + WS_GDOPS); F.gdc = (float*)(ws + WS_GDC);
        F.pq = (float*)(ws + WS_PQ); F.sst = (float*)(ws + WS_SST); F.dots = F.pq; F.li = (bf16_t*)(ws + WS_SST); F.wl = (bf16_t*)(ws + WS_WL);
        if (ph == 0) {
#ifdef PROBE_P0
            for (int rep = 0; rep < 2; ++rep) {
#else
            {
#endif
            for (size_t i = (size_t)obid() * 512 + otid(); i < (size_t)M * D / 4; i += (size_t)G * 512) {
                const f32x4 v = (i < (size_t)MP * D / 4) ? ((const f32x4*)p.in[0])[i] : ((const f32x4*)p.in[1])[i - (size_t)MP * D / 4];
                ((f32x4*)F.xf)[i] = v; u32x2 w; w.x = pk2(v[0], v[1]); w.y = pk2(v[2], v[3]); ((u32x2*)F.xb)[i] = w; }
            conv_jobs(F, -1, 0, 0x07, ldsf, obid(), G);
            conv_lora(F);
            }
        } else {
            const int l = (ph - 1) / PPL, pi = (ph - 1) % PPL;
            if (pi == 0 || pi == 12) {
                pg8::Gemm g{F.xb, pi == 0 ? F.w1a : F.w2a, M, 2 * FF, D, D}; pg8::StaticOrder S; S.init(M, 2 * FF, G, obid());
                EpiSwiGLU E{F.h};
#ifdef PROBE_G1
                for (int rep = 0; rep < (pi == 0 ? 2 : 1); ++rep)
#endif
                pg8::gemm_phase<EpiSwiGLU, pg8::StaticOrder, false>(ldsl, g, S, E, nullptr);
            } else if (pi == 1 || pi == 10 || pi == 13) {
                const bf16_t* Ap = pi == 10 ? F.mix : F.h; const bf16_t* Bp = pi == 1 ? F.w1b : (pi == 10 ? F.wout : F.w2b); const int Kd = pi == 10 ? D : FF;
                { pg8::Gemm g{Ap, Bp, MP, D, Kd, Kd}; pg8::StaticOrder S; S.init(MP, D, G, obid());
                  EpiResid E{F.xf, F.z, pi == 10 ? 1.0f : 0.5f};
#ifdef PROBE_G2
                  for (int rep = 0; rep < (pi == 1 ? 2 : 1); ++rep)
#endif
                  pg8::gemm_phase<EpiResid, pg8::StaticOrder, false>(ldsl, g, S, E, nullptr); }
                { const int nsl = Kd / 256, bid = obid(), u = bid & 7, sl = bid >> 3;
                  pg8::Gemm g{Ap + (size_t)MP * Kd + sl * 256, Bp + sl * 256, MS, D, 256, Kd}; OneUnit S{u >> 2, u & 3, sl < nsl};
                  EpiSlab E{F.slab + (size_t)sl * MS * D};
#ifdef PROBE_G2
                  for (int rep = 0; rep < (pi == 1 ? 2 : 1); ++rep)
#endif
                  pg8::gemm_phase<EpiSlab, OneUnit, false>(ldsl, g, S, E, nullptr); }
            } else if (pi == 3) {
                pg8::Gemm g{F.xb, F.win, M, NPP, D, D}; pg8::StaticOrder S; S.init(M, NPP, G, obid());
                pg8::EpiBf16<0> E{F.proj, NPP, nullptr, 0, 0};
#ifdef PROBE_G3
                for (int rep = 0; rep < 2; ++rep)
#endif
                pg8::gemm_phase<pg8::EpiBf16<0>, pg8::StaticOrder, false>(ldsl, g, S, E, nullptr);
            } else if (pi == 5) {
                pg8::Gemm g{F.li, F.wl + (size_t)l * 768 * 256, M, 768, 256, 256}; pg8::StaticOrder S; S.init(M, 768, G, obid());
                pg8::EpiF32 E{F.dots, 768, nullptr};
#ifdef PROBE_GL
                for (int rep = 0; rep < 2; ++rep)
#endif
                pg8::gemm_phase<pg8::EpiF32, pg8::StaticOrder, false>(ldsl, g, S, E, nullptr);
            } else if (pi == 2 || pi == 11 || pi == 14) {
                const int gi = pi == 2 ? 10 : (pi == 11 ? 31 : 35);
#ifdef PROBE_LN
                for (int rep = 0; rep < (pi == 2 ? 2 : 1); ++rep)
#endif
                ln_phase(F, p.in[gi] + l * D, p.in[gi + 1] + l * D, (pi == 14 && l == DEPTH - 1) ? F.out : nullptr, pi == 11 ? D / 256 : FF / 256, pi == 11 ? 1.0f : 0.5f);
                if (pi == 2) { __syncthreads(); conv_jobs(F, -1, l + 1, 0x03, ldsf, obid(), G); }
            } else if (pi == 4) {
#ifdef PROBE_P4
                for (int rep = 0; rep < 2; ++rep) {
#else
                {
#endif
                pre_a(F, l);
                copy_states(F, l);
                __syncthreads(); conv_jobs(F, -1, l + 1, 0x04, ldsf, obid(), G);
                }
            } else if (pi == 6) {
#ifdef PROBE_PRENS
                pre_b<false>(F, l);
#endif
                pre_b<true>(F, l);
#ifdef PROBE_PRE
                pre_b<true>(F, l);
#endif
            } else if (pi == 7) {
                scan_pass1(F, ldsf);
#ifdef PROBE_S1
                scan_pass1(F, ldsf);
#endif
            } else if (pi == 8) {
#ifdef PROBE_S2
                for (int rep = 0; rep < 2; ++rep) {
#else
                {
#endif
                const int ncb = 32;
                if (obid() < ncb) chain_prop(F, l, obid(), ldsf);
                else {
                    const int vb = obid() - ncb, nvb = G - ncb;
#ifdef PROBE_SWAP
                    for (int it = vb; it < 256; it += nvb) swa_prompt_item(F, l, it, lds);
#endif
                    for (int it = vb; it < 256; it += nvb) swa_prompt_item(F, l, it, lds);
                    for (int it = vb; it < 256; it += nvb) swa_sample_item(F, l, it, lds);
                    __syncthreads();
                    scan_sample(F, l, vb, nvb, ldsf);
#ifdef PROBE_SSMP
                    scan_sample(F, l, vb, nvb, ldsf);
#endif
                    __syncthreads();
                    conv_jobs(F, l, -1, 0x38, ldsf, vb, nvb);
                }
                __syncthreads();
                }
            } else if (pi == 9) {
                scan_pass3(F, l, ldsf);
#ifdef PROBE_S3
                scan_pass3(F, l, ldsf);
#endif
            }
        }
        if (ph + 1 < p.ph_hi) { if (ph == p.ph_lo) grid.sync(); else { XcdBarrier xb; xb.bar = (unsigned*)(p.ws + WS_BAR); xb.x = xb_xcc_id(); xb.st = (volatile XB_LAS unsigned*)(lds + pg8::STAGE_BYTES); xcd_barrier(xb); } }
#ifdef PROBE_SYNC
        if (ph + 1 < p.ph_hi) { XcdBarrier xb; xb.bar = (unsigned*)(p.ws + WS_BAR); xb.x = xb_xcc_id(); xb.st = (volatile XB_LAS unsigned*)(lds + pg8::STAGE_BYTES); xcd_barrier(xb); }
#endif
    }
}
}

extern "C" void kernel_launch(void* const* d_in, const int* in_sizes, int n_in, void* d_out, int out_size, void* d_ws, size_t ws_size, hipStream_t stream) {
    static int grid = 0;
    if (grid == 0) {
        int dev = 0, cus = 0, per_cu = 0;
        hipGetDevice(&dev);
        hipDeviceGetAttribute(&cus, hipDeviceAttributeMultiprocessorCount, dev);
        hipFuncSetAttribute((const void*)mk::fwd_megakernel, hipFuncAttributeMaxDynamicSharedMemorySize, mk::LDS_BYTES);
        hipOccupancyMaxActiveBlocksPerMultiprocessor(&per_cu, (const void*)mk::fwd_megakernel, 512, mk::LDS_BYTES);
        (void)hipGetLastError();
        if (per_cu < 1) per_cu = 1;
        if (per_cu > 1) per_cu = 1;
        grid = cus * per_cu;
        if (n_in != 37 || ws_size < mk::WS_END || (size_t)out_size != mk::O_END)
            fprintf(stderr, "kernel_launch: unexpected shapes: n_in %d ws %zu (need %zu) out %d (expect %zu)\n", n_in, ws_size, (size_t)mk::WS_END, out_size, (size_t)mk::O_END);
    }
    mk::Params p{};
    for (int i = 0; i < 37; ++i) p.in[i] = (const float*)d_in[i];
    p.out = (float*)d_out; p.ws = (unsigned char*)d_ws; p.ph_lo = 0; p.ph_hi = mk::NPH;
    (void)hipMemsetAsync((unsigned char*)d_ws + mk::WS_BAR, 0, 16384, stream);
    void* args[] = {&p};
    hipError_t e = hipLaunchCooperativeKernel((const void*)mk::fwd_megakernel, dim3(grid), dim3(512), args, mk::LDS_BYTES, stream);
    if (e != hipSuccess) fprintf(stderr, "cooperative launch failed: %s (grid %d)\n", hipGetErrorString(e), grid);
}
```

```cpp
#include <hip/hip_runtime.h>
#include <hip/hip_cooperative_groups.h>
#include <cstdio>
#include <cstdint>
namespace cg = cooperative_groups;
namespace pg8 {
#define PG8_LAS __attribute__((address_space(3)))
typedef unsigned short bf16_t;
typedef short bf16x8 __attribute__((ext_vector_type(8)));
typedef float f32x4 __attribute__((ext_vector_type(4)));
typedef unsigned u32x4 __attribute__((ext_vector_type(4)));
constexpr int BM = 256, BK = 64, HALF = 128, HTB = HALF * BK * 2  , STAGE_BYTES = 8 * HTB, NXCD = 8, WGM = 8;

__host__ __device__ __forceinline__ int lds_byte(int r, int c) { const int st = (r >> 4) * 2 + (c >> 5), rr = r & 15, cc = c & 31, ob = rr * 64 + cc * 2; return st * 1024 + (ob ^ (((ob >> 9) & 1) << 5)); }
__host__ __device__ __forceinline__ void stage_rc(int b, int& R, int& C) { const int st = b / 1024, sb = b % 1024, swz = sb ^ (((sb >> 9) & 1) << 5); R = (st >> 1) * 16 + swz / 64; C = (st & 1) * 32 + (swz % 64) / 2; }
__host__ __device__ __forceinline__ int perm32(int rho) { const int n = rho >> 4, i = rho & 15; return 8 * (i >> 2) + 4 * n + (i & 3); }

struct Unit { int pm, pn; };
struct Gemm { const bf16_t* A; const bf16_t* Bt; int M, N, K, ld; };

struct StaticOrder {
    int nM, nN, nwg, G, c;
    __host__ __device__ void init(int M, int N, int G_, int c_) { nM = M / BM; nN = N / BM; nwg = nM * nN; G = G_; c = c_; }
    __host__ __device__ bool next(int i, Unit& u) const {
        const long L = (long)i * G + c; if (L >= nwg) return false;
        int wgid = (int)L; { const int q = nwg / NXCD, r = nwg % NXCD, xcd = wgid % NXCD, off = wgid / NXCD; wgid = (xcd < r ? xcd * (q + 1) : r * (q + 1) + (xcd - r) * q) + off; }
        const int nig = WGM * nN, gid = wgid / nig, fm = gid * WGM, gsz = (nM - fm) < WGM ? (nM - fm) : WGM;
        u.pm = fm + ((wgid % nig) % gsz); u.pn = (wgid % nig) / gsz; return true;
    }
    __device__ __forceinline__ void a_ready(const Unit&) const {}
    __device__ __forceinline__ void done(const Unit&) const {}
};
struct CountedOrder : StaticOrder {
    const unsigned* ready; unsigned need; unsigned* tmo;
    __device__ __forceinline__ void a_ready(const Unit& u) const {
        if (threadIdx.x < 64) {
            const unsigned long long t0 = __builtin_amdgcn_s_memrealtime(); unsigned polls = 0;
            while ((unsigned)__builtin_amdgcn_readfirstlane(__hip_atomic_load(ready + 64 * u.pm, __ATOMIC_RELAXED, __HIP_MEMORY_SCOPE_AGENT)) < need) {
                if ((++polls & 255u) == 0u && __builtin_amdgcn_readfirstlane(__hip_atomic_load(tmo, __ATOMIC_RELAXED, __HIP_MEMORY_SCOPE_AGENT)) != 0u) break;
                if (__builtin_amdgcn_s_memrealtime() - t0 > 2000000ull) {
                    if (threadIdx.x == 0) { unsigned expect = 0u; __hip_atomic_compare_exchange_strong(tmo + 1, &expect, 0x600u | (unsigned)(u.pm & 0xff), __ATOMIC_RELAXED, __ATOMIC_RELAXED, __HIP_MEMORY_SCOPE_AGENT); __hip_atomic_store(tmo, 1u, __ATOMIC_RELAXED, __HIP_MEMORY_SCOPE_AGENT); }
                    break; }
                __builtin_amdgcn_s_sleep(2); }
            __builtin_amdgcn_fence(__ATOMIC_ACQUIRE, "agent");
            asm volatile("s_waitcnt vmcnt(0)" ::: "memory");
        }
#if !defined(BROKEN_HOOK_NO_BARRIER)
        asm volatile("" ::: "memory"); __builtin_amdgcn_s_barrier(); asm volatile("" ::: "memory");
#endif
    }
};

__device__ __forceinline__ unsigned cvt_pk_bf16(float lo, float hi) { unsigned r; asm volatile("v_cvt_pk_bf16_f32 %0, %1, %2" : "=v"(r) : "v"(lo), "v"(hi)); return r; }
typedef float f32x2 __attribute__((ext_vector_type(2)));
__device__ __forceinline__ f32x2 gelu_pk(f32x2 v) {
    const f32x2 av = __builtin_elementwise_abs(v), d = av * 0.2316418882f + 1.0f;
    f32x2 t; t.x = __builtin_amdgcn_rcpf(d.x); t.y = __builtin_amdgcn_rcpf(d.y);
    f32x2 q = t * 0.5307027145f + (-0.7265760135f); q = q * t + 0.7107068705f; q = q * t + (-0.142248368f); q = q * t + 0.127414796f; q = q * t;
    const f32x2 s = (v * v) * (-0.72134752044f);
    f32x2 e; e.x = __builtin_amdgcn_exp2f(s.x); e.y = __builtin_amdgcn_exp2f(s.y);
    const f32x2 m = v * (q * e), r = v - m;
    f32x2 o; o.x = v.x < 0.f ? m.x : r.x; o.y = v.y < 0.f ? m.y : r.y; return o;
}

struct EpiF32 {
    static constexpr bool PERM = false, AFTER_DRAIN = false;
    float* C; int ldc; const float* bias;
    __device__ __forceinline__ void operator()(const f32x4 (&acc)[2][2][4][2], const Unit& u, int wr, int wc, int fr, int fq) const {
        const int row0 = u.pm * BM + wr * 64 + fr, col0 = u.pn * BM + wc * 32 + 4 * fq;
        f32x4 bv[2][2];
#pragma unroll
        for (int bj = 0; bj < 2; ++bj)
#pragma unroll
            for (int n = 0; n < 2; ++n) bv[bj][n] = bias ? *(const f32x4*)(bias + col0 + bj * HALF + n * 16) : (f32x4){0.f, 0.f, 0.f, 0.f};
#pragma unroll
        for (int ai = 0; ai < 2; ++ai)
#pragma unroll
            for (int m = 0; m < 4; ++m) { float* rowp = C + (size_t)(row0 + ai * HALF + m * 16) * ldc + col0;
#pragma unroll
                for (int bj = 0; bj < 2; ++bj)
#pragma unroll
                    for (int n = 0; n < 2; ++n) *(f32x4*)(rowp + bj * HALF + n * 16) = acc[ai][bj][m][n] + bv[bj][n]; }
    }
};
template <int ACT  > struct EpiBf16 {
    static constexpr bool PERM = true, AFTER_DRAIN = false;
    bf16_t* O; int ldc; const float* bias; int split_cols; size_t split_stride;
    __device__ __forceinline__ void operator()(const f32x4 (&acc)[2][2][4][2], const Unit& u, int wr, int wc, int fr, int fq) const {
        const int row0 = u.pm * BM + wr * 64 + fr; int colt = u.pn * BM; bf16_t* base = O;
        if (split_cols) { const int t = colt / split_cols; base += (size_t)t * split_stride; colt -= t * split_cols; }
        const int col0 = colt + wc * 32 + 8 * fq, bcol0 = u.pn * BM + wc * 32 + 8 * fq;
        f32x4 bv[2][2];
#pragma unroll
        for (int bj = 0; bj < 2; ++bj)
#pragma unroll
            for (int n = 0; n < 2; ++n) bv[bj][n] = bias ? *(const f32x4*)(bias + bcol0 + bj * HALF + 4 * n) : (f32x4){0.f, 0.f, 0.f, 0.f};
#pragma unroll
        for (int ai = 0; ai < 2; ++ai)
#pragma unroll
            for (int m = 0; m < 4; ++m) { bf16_t* rowp = base + (size_t)(row0 + ai * HALF + m * 16) * ldc + col0;
#pragma unroll
                for (int bj = 0; bj < 2; ++bj) { f32x4 v0 = acc[ai][bj][m][0] + bv[bj][0], v1 = acc[ai][bj][m][1] + bv[bj][1];
                    if (ACT == 1) { f32x2 a = gelu_pk((f32x2){v0[0], v0[1]}), b = gelu_pk((f32x2){v0[2], v0[3]}), c = gelu_pk((f32x2){v1[0], v1[1]}), d = gelu_pk((f32x2){v1[2], v1[3]});
                        v0 = (f32x4){a.x, a.y, b.x, b.y}; v1 = (f32x4){c.x, c.y, d.x, d.y}; }
                    if (ACT == 2) {
#pragma unroll
                        for (int j = 0; j < 4; ++j) { v0[j] = 0.5f * v0[j] * (1.0f + erff(v0[j] * 0.70710678f)); v1[j] = 0.5f * v1[j] * (1.0f + erff(v1[j] * 0.70710678f)); } }
                    u32x4 w; w.x = cvt_pk_bf16(v0[0], v0[1]); w.y = cvt_pk_bf16(v0[2], v0[3]); w.z = cvt_pk_bf16(v1[0], v1[1]); w.w = cvt_pk_bf16(v1[2], v1[3]);
                    *(u32x4*)(rowp + bj * HALF) = w; } }
    }
};
template <class Epi, class Sched, bool STAMP = false>
__device__ __forceinline__ void gemm_phase(PG8_LAS unsigned char* lds, const Gemm g, const Sched& S, const Epi& E, unsigned long long* stamps) {
    int tid = threadIdx.x; asm volatile("" : "+v"(tid)); const int wid = __builtin_amdgcn_readfirstlane(tid >> 6), lane = tid & 63, wr = wid >> 2, wc = wid & 3, fr = lane & 15, fq = lane >> 4;
    const int K = g.K, nt = K / BK;
    int ts_lo = 0, ts_hi = 0, nts = 0; const unsigned long long rt_entry = STAMP ? (unsigned long long)wall_clock64() : 0ull;
#define PG8_STAMP() do { if (STAMP && wid == 0 && nts < 64) { const unsigned long long _c = (unsigned long long)clock64(); \
        ts_lo = (lane == nts) ? (int)(unsigned)_c : ts_lo; ts_hi = (lane == nts) ? (int)(unsigned)(_c >> 32) : ts_hi; ++nts; } } while (0)
    PG8_STAMP();
    unsigned voffA[2], voffB[2];
#pragma unroll
    for (int i = 0; i < 2; ++i) { int R, C; stage_rc(tid * 16 + i * 8192, R, C); const int Rb = Epi::PERM ? ((R & ~31) + perm32(R & 31)) : R;
        voffA[i] = (unsigned)(R * g.ld + C) * 2u; voffB[i] = (unsigned)(Rb * g.ld + C) * 2u; }
    const size_t kstep = (size_t)(BK * 2);
    const size_t hstep = (size_t)HALF * g.ld * 2;
    const size_t tstep = 2 * hstep;
    const unsigned ldsw = (unsigned)wid * 1024u;
    const int aoff = lds_byte(wr * 64 + fr, fq * 8), boff = lds_byte(wc * 32 + fr, fq * 8);
#define PG8_SA(b, h) (((b) * 2 + (h)) * HTB)
#define PG8_SB(b, h) ((4 + (b) * 2 + (h)) * HTB)
#define PG8_STAGE(bufoff, gbase, voff) do { _Pragma("unroll") for (int _i = 0; _i < 2; ++_i) \
        __builtin_amdgcn_global_load_lds((const unsigned*)((const char*)(gbase) + (voff)[_i]), (PG8_LAS unsigned*)(lds + (bufoff) + ldsw + _i * 8192), 16, 0, 0); } while (0)
#define PG8_LDA(dst, b, h) do { _Pragma("unroll") for (int m = 0; m < 4; ++m) _Pragma("unroll") for (int k = 0; k < 2; ++k) dst[m][k] = *(const PG8_LAS bf16x8*)(lds + PG8_SA(b, h) + aoff + m * 2048 + k * 1024); } while (0)
#define PG8_LDB(dst, b, h) do { _Pragma("unroll") for (int n = 0; n < 2; ++n) _Pragma("unroll") for (int k = 0; k < 2; ++k) dst[n][k] = *(const PG8_LAS bf16x8*)(lds + PG8_SB(b, h) + boff + n * 2048 + k * 1024); } while (0)
#define PG8_MMA(ai, bj, At, Bt) do { __builtin_amdgcn_s_setprio(1); _Pragma("unroll") for (int m = 0; m < 4; ++m) _Pragma("unroll") for (int n = 0; n < 2; ++n) _Pragma("unroll") for (int k = 0; k < 2; ++k) \
        acc[ai][bj][m][n] = __builtin_amdgcn_mfma_f32_16x16x32_bf16(Bt[n][k], At[m][k], acc[ai][bj][m][n], 0, 0, 0); __builtin_amdgcn_s_setprio(0); } while (0)
#define PG8_WAIT_V(n) asm volatile("s_waitcnt vmcnt(" #n ")" ::: "memory")
#define PG8_WAIT_L(n) asm volatile("s_waitcnt lgkmcnt(" #n ")" ::: "memory")
#define PG8_BAR __builtin_amdgcn_s_barrier()
#define PG8_SCHED __builtin_amdgcn_sched_barrier(0)
    Unit cur, nxt; int ui = 0;
    if (!S.next(0, cur)) return;
    f32x4 acc[2][2][4][2];
#pragma unroll
    for (int a = 0; a < 2; ++a)
#pragma unroll
        for (int b = 0; b < 2; ++b)
#pragma unroll
            for (int m = 0; m < 4; ++m)
#pragma unroll
                for (int n = 0; n < 2; ++n) acc[a][b][m][n] = (f32x4){0.f, 0.f, 0.f, 0.f};
    bf16x8 At[4][2], B0[2][2], B1[2][2];
    const char* cA = (const char*)g.A + (size_t)cur.pm * tstep; const char* cB = (const char*)g.Bt + (size_t)cur.pn * tstep;
    S.a_ready(cur);
    PG8_STAGE(PG8_SB(0, 0), cB, voffB); PG8_STAGE(PG8_SA(0, 0), cA, voffA); PG8_STAGE(PG8_SB(0, 1), cB + hstep, voffB); PG8_STAGE(PG8_SA(0, 1), cA + hstep, voffA);
    if (wr == 1) PG8_BAR;
    PG8_WAIT_V(4); PG8_BAR;
    PG8_STAGE(PG8_SB(1, 0), cB + kstep, voffB); PG8_STAGE(PG8_SA(1, 0), cA + kstep, voffA); PG8_STAGE(PG8_SB(1, 1), cB + hstep + kstep, voffB);
    PG8_WAIT_V(6); PG8_BAR;
    PG8_STAMP();
    for (;;) {
        const bool has_next = S.next(ui + 1, nxt);
        const char* nA = has_next ? (const char*)g.A + (size_t)nxt.pm * tstep : cA; const char* nB = has_next ? (const char*)g.Bt + (size_t)nxt.pn * tstep : cB;
        for (int t = 0; t < nt; t += 2) {
            const bool last = (t == nt - 2);
            const char* a1 = cA + (size_t)(t + 1) * kstep;
            const char* a2 = last ? nA : cA + (size_t)(t + 2) * kstep; const char* b2 = last ? nB : cB + (size_t)(t + 2) * kstep;
            const char* a3 = a2 + kstep; const char* b3 = b2 + kstep;
            if (last && has_next) S.a_ready(nxt);
            PG8_LDB(B0, 0, 0); PG8_SCHED; PG8_LDA(At, 0, 0); PG8_STAGE(PG8_SA(1, 1), a1 + hstep, voffA);
            PG8_WAIT_L(8); PG8_BAR; PG8_WAIT_L(0); PG8_MMA(0, 0, At, B0); PG8_BAR; PG8_SCHED;
            PG8_LDB(B1, 0, 1); PG8_STAGE(PG8_SB(0, 0), b2, voffB);
            PG8_BAR; PG8_WAIT_L(0); PG8_MMA(0, 1, At, B1); PG8_BAR;
            PG8_LDA(At, 0, 1); PG8_STAGE(PG8_SA(0, 0), a2, voffA);
            PG8_BAR; PG8_WAIT_L(0); PG8_MMA(1, 0, At, B0); PG8_BAR; PG8_SCHED;
            PG8_STAGE(PG8_SB(0, 1), b2 + hstep, voffB);
            PG8_WAIT_V(6); PG8_BAR; PG8_MMA(1, 1, At, B1); PG8_BAR;
            PG8_LDB(B0, 1, 0); PG8_SCHED; PG8_LDA(At, 1, 0); PG8_STAGE(PG8_SA(0, 1), a2 + hstep, voffA);
            PG8_WAIT_L(8); PG8_BAR; PG8_WAIT_L(0); PG8_MMA(0, 0, At, B0); PG8_BAR; PG8_SCHED;
            PG8_LDB(B1, 1, 1); PG8_STAGE(PG8_SB(1, 0), b3, voffB);
            PG8_BAR; PG8_WAIT_L(0); PG8_MMA(0, 1, At, B1); PG8_BAR;
            PG8_LDA(At, 1, 1); PG8_STAGE(PG8_SA(1, 0), a3, voffA);
            PG8_BAR; PG8_WAIT_L(0); PG8_MMA(1, 0, At, B0); PG8_BAR; PG8_SCHED;
            PG8_STAGE(PG8_SB(1, 1), b3 + hstep, voffB);
            PG8_WAIT_V(6); PG8_BAR; PG8_MMA(1, 1, At, B1); PG8_BAR;
        }
        PG8_STAMP();
        if constexpr (!Epi::AFTER_DRAIN) { E(acc, cur, wr, wc, fr, fq); S.done(cur); }
        PG8_STAMP();
        if (!has_next) break;
#pragma unroll
        for (int a = 0; a < 2; ++a)
#pragma unroll
            for (int b = 0; b < 2; ++b)
#pragma unroll
                for (int m = 0; m < 4; ++m)
#pragma unroll
                    for (int n = 0; n < 2; ++n) acc[a][b][m][n] = (f32x4){0.f, 0.f, 0.f, 0.f};
        cur = nxt; cA = nA; cB = nB; ++ui;
    }
    PG8_WAIT_V(0);
    if (wr == 0) PG8_BAR;
    PG8_BAR;
    if constexpr (Epi::AFTER_DRAIN) { E.fused(acc, cur, wr, wc, fr, fq, lds, wid, lane); S.done(cur); }
    PG8_STAMP();
    if (STAMP && wid == 0) { stamps[lane] = lane < nts ? (((unsigned long long)(unsigned)ts_hi << 32) | (unsigned)ts_lo) : 0ull;
        if (lane == 62) stamps[62] = rt_entry; if (lane == 63) stamps[63] = (unsigned long long)wall_clock64(); }
#undef PG8_STAMP
#undef PG8_SA
#undef PG8_SB
#undef PG8_STAGE
#undef PG8_LDA
#undef PG8_LDB
#undef PG8_MMA
#undef PG8_WAIT_V
#undef PG8_WAIT_L
#undef PG8_BAR
#undef PG8_SCHED
}
}
#define XB_TMO      128
#define XB_XCNT(j)  (256  + 64 * (j))
#define XB_XSUB(j)  (1280 + 64 * (j))
#define XB_XGEN(j)  (2304 + 64 * (j))
#define XB_TOP      3328
#define XB_TOPGEN   3392
#define XCD_BAR_WORDS 3456
#define XB_SPIN_CAP (1u << 22)
#define XB_LAS __attribute__((address_space(3)))

__device__ __forceinline__ unsigned xb_ld(unsigned* p)              { return __hip_atomic_load(p, __ATOMIC_RELAXED, __HIP_MEMORY_SCOPE_AGENT); }
__device__ __forceinline__ unsigned xb_add(unsigned* p, unsigned v) { return __hip_atomic_fetch_add(p, v, __ATOMIC_RELAXED, __HIP_MEMORY_SCOPE_AGENT); }
__device__ __forceinline__ unsigned xb_xcc_id() { return (unsigned)__builtin_amdgcn_s_getreg((3 << 11) | 20) & 0xFu; }
#define XB_SPIN(cond, bar) do { unsigned _sp = 0; while (cond) { __builtin_amdgcn_s_sleep(1); \
    if ((++_sp & 255u) == 0u) { if (xb_ld(&(bar)[XB_TMO])) break; if (_sp > XB_SPIN_CAP) { atomicAdd(&(bar)[XB_TMO], 1u); break; } } } } while (0)

struct XcdBarrier {
    unsigned* bar; unsigned x;
    volatile XB_LAS unsigned* st;
};

__device__ __forceinline__ XcdBarrier xcd_barrier_post(unsigned* bar, volatile XB_LAS unsigned* st) {
    XcdBarrier b; b.bar = bar; b.x = xb_xcc_id(); b.st = st;
    if (threadIdx.x == 0) (void)xb_add(&bar[XB_XCNT(b.x)], 1u);
    return b;
}
__device__ __forceinline__ void xcd_barrier_complete(unsigned* bar, unsigned x, unsigned& nloc, unsigned& nx) {
    const unsigned G = gridDim.x * gridDim.y * gridDim.z;
    unsigned sum, cnt, mine, sp = 0u;
    for (;;) {
        sum = 0u; cnt = 0u; mine = 0u;
#pragma unroll
        for (unsigned j = 0; j < 16; ++j) { const unsigned c = xb_ld(&bar[XB_XCNT(j)]); sum += c; cnt += (c > 0u) ? 1u : 0u; mine = (j == x) ? c : mine; }
        if (sum == G) break;
        __builtin_amdgcn_s_sleep(1);
        if ((++sp & 255u) == 0u) { if (xb_ld(&bar[XB_TMO])) break; if (sp > XB_SPIN_CAP) { atomicAdd(&bar[XB_TMO], 1u); break; } }
    }
    nloc = mine > 0u ? mine : 1u; nx = cnt > 0u ? cnt : 1u;
}

__device__ __forceinline__ void xcd_barrier(const XcdBarrier& b) {
    asm volatile("s_waitcnt vmcnt(0)" ::: "memory");
    __syncthreads();
    if (threadIdx.x == 0) {
        unsigned* bar = b.bar;
        __builtin_amdgcn_s_waitcnt(0);
        unsigned nloc = b.st[0], nx = b.st[1];
        if (nloc == 0u) { xcd_barrier_complete(bar, b.x, nloc, nx); b.st[0] = nloc; b.st[1] = nx; }
        const unsigned old = xb_add(&bar[XB_XSUB(b.x)], 1u);
        const unsigned gen = old / nloc;
        if (old + 1u == (gen + 1u) * nloc) {
            __builtin_amdgcn_fence(__ATOMIC_RELEASE, "agent");
            asm volatile("s_waitcnt vmcnt(0)" ::: "memory");
            const unsigned og = xb_add(&bar[XB_TOP], 1u);
            const unsigned tg = og / nx;
            if (og + 1u == (tg + 1u) * nx) xb_add(&bar[XB_TOPGEN], 1u);
            else XB_SPIN(xb_ld(&bar[XB_TOPGEN]) == tg, bar);
            __builtin_amdgcn_fence(__ATOMIC_ACQUIRE, "agent");
            xb_add(&bar[XB_XGEN(b.x)], 1u);
            asm volatile("s_waitcnt vmcnt(0)" ::: "memory");
        } else {
            XB_SPIN(xb_ld(&bar[XB_XGEN(b.x)]) == gen, bar);
            __builtin_amdgcn_fence(__ATOMIC_ACQUIRE, "agent");
            asm volatile("s_waitcnt vmcnt(0)" ::: "memory");
        }
    }
    __syncthreads();
}

namespace mk {
using pg8::bf16_t; using pg8::bf16x8; using pg8::f32x4; using pg8::u32x4;
typedef float f32x2 __attribute__((ext_vector_type(2)));
typedef float f32x8 __attribute__((ext_vector_type(8)));
typedef float f32x16 __attribute__((ext_vector_type(16)));
typedef unsigned u32x2 __attribute__((ext_vector_type(2)));
#define MK_CAS __attribute__((address_space(4)))

constexpr int D = 1024, FF = 2816, MP = 16384, MS = 512, M = MP + MS, SEQ = 4096, NPP = 2816, NPROJ = 2696;
constexpr int SO = 896, GO = 1664, DEPTH = 4, PPL = 15, NPH = 1 + PPL * DEPTH;
constexpr int CH_L = 64, NCH = SEQ / CH_L;
constexpr float ALPHA = 1.6817928305074290f;

constexpr size_t SZ_W1A = (size_t)2 * FF * D * 2, SZ_W1B = (size_t)D * FF * 2, SZ_WIN = (size_t)NPP * D * 2, SZ_WOUT = (size_t)D * D * 2;
constexpr size_t WS_W1A = 0, WS_W1B = WS_W1A + SZ_W1A, WS_WIN = WS_W1B + SZ_W1B, WS_WOUT = WS_WIN + SZ_WIN, WS_W2A = WS_WOUT + SZ_WOUT, WS_W2B = WS_W2A + SZ_W1A;
constexpr size_t WS_XF = WS_W2B + SZ_W1B;
constexpr size_t WS_XB = WS_XF + (size_t)M * D * 4;
constexpr size_t WS_PROJ = WS_XB + (size_t)M * D * 2;
constexpr size_t WS_R2 = WS_PROJ + (size_t)M * NPP * 2;
constexpr size_t WS_RWOPS = WS_R2;
constexpr size_t WS_RWC = WS_RWOPS + (size_t)M * 4 * 324 * 4;
constexpr size_t WS_GDOPS = WS_RWC + (size_t)M * 4 * 128 * 4;
constexpr size_t WS_GDC = WS_GDOPS + (size_t)M * 4 * 136 * 4;
constexpr size_t WS_PQ = WS_GDC + (size_t)M * 4 * 128 * 4;
constexpr size_t WS_SST = WS_PQ + (size_t)32 * NCH * 2 * 4096 * 4;
constexpr size_t WS_WL = WS_SST + (size_t)32 * NCH * 4096 * 4;
constexpr size_t WS_BAR = WS_WL + (size_t)DEPTH * 768 * 256 * 2;
constexpr size_t WS_END = WS_BAR + 16384;

constexpr size_t O_YP = 0, O_YS = O_YP + (size_t)MP * D, O_PRW = O_YS + (size_t)MS * D, O_PRS = O_PRW + 4 * 4 * 4 * 4096, O_PSK = O_PRS + 4 * 4 * 896,
                 O_PSV = O_PSK + 4 * 4 * 128 * 128, O_PGD = O_PSV + 4 * 4 * 128 * 128, O_PGC = O_PGD + 4 * 4 * 4 * 4096, O_SRW = O_PGC + 4 * 4 * 3 * 768,
                 O_SRS = O_SRW + (size_t)4 * 128 * 4 * 4096, O_SSK = O_SRS + 4 * 128 * 896, O_SSV = O_SSK + (size_t)4 * 128 * 128 * 128,
                 O_SGD = O_SSV + (size_t)4 * 128 * 128 * 128, O_SGC = O_SGD + (size_t)4 * 128 * 4 * 4096, O_END = O_SGC + 4 * 128 * 3 * 768;

struct Params { const float* in[37]; float* out; unsigned char* ws; int ph_lo, ph_hi; };

struct Frame {
    const float* in[37]; float* out;
    bf16_t *w1a, *w1b, *win, *wout, *w2a, *w2b, *xb, *mix, *proj, *h;
    bf16_t *li, *wl;
    float *xf, *z, *slab, *rwops, *rwc, *gdops, *gdc, *pq, *sst, *dots;
};

__device__ __forceinline__ float bf2f(bf16_t v) { return __uint_as_float(((unsigned)v) << 16); }
__device__ __forceinline__ unsigned pk2(float a, float b) { return pg8::cvt_pk_bf16(a, b); }
__device__ __forceinline__ bf16_t f2bf(float a) { return (bf16_t)(pk2(a, a) & 0xffffu); }
__device__ __forceinline__ float wsum(float v) {
    v += __int_as_float(__builtin_amdgcn_update_dpp(0, __float_as_int(v), 0xB1, 0xf, 0xf, false));
    v += __int_as_float(__builtin_amdgcn_update_dpp(0, __float_as_int(v), 0x4E, 0xf, 0xf, false));
    v += __int_as_float(__builtin_amdgcn_update_dpp(0, __float_as_int(v), 0x141, 0xf, 0xf, false));
    v += __int_as_float(__builtin_amdgcn_update_dpp(0, __float_as_int(v), 0x140, 0xf, 0xf, false));
    v += __int_as_float(__builtin_amdgcn_update_dpp(0, __float_as_int(v), 0x142, 0xa, 0xf, false));
    v += __int_as_float(__builtin_amdgcn_update_dpp(0, __float_as_int(v), 0x143, 0xc, 0xf, false));
    return __int_as_float(__builtin_amdgcn_readlane(__float_as_int(v), 63)); }
__device__ __forceinline__ float sigm(float x) { return __builtin_amdgcn_rcpf(1.f + __expf(-x)); }
__device__ __forceinline__ float silu(float x) { return x * __builtin_amdgcn_rcpf(1.f + __expf(-x)); }
__device__ __forceinline__ float softplus(float x) { return fmaxf(x, 0.f) + log1pf(expf(-fabsf(x))); }
__device__ __forceinline__ int otid() { int t = threadIdx.x; asm volatile("" : "+v"(t)); return t; }
__device__ __forceinline__ int obid() { int b = blockIdx.x; asm volatile("" : "+s"(b)); return b; }
__device__ __forceinline__ const MK_CAS float* launder(const float* p) { unsigned long long a = (unsigned long long)p; asm volatile("" : "+s"(a)); return (const MK_CAS float*)a; }

struct EpiSwiGLU {
    static constexpr bool PERM = true, AFTER_DRAIN = false;
    bf16_t* O;
    __device__ __forceinline__ void operator()(const f32x4 (&acc)[2][2][4][2], const pg8::Unit& u, int wr, int wc, int fr, int fq) const {
        const int row0 = u.pm * 256 + wr * 64 + fr, col0 = u.pn * 128 + wc * 32 + 8 * fq;
#pragma unroll
        for (int ai = 0; ai < 2; ++ai)
#pragma unroll
            for (int m = 0; m < 4; ++m) {
                bf16_t* rowp = O + (size_t)(row0 + ai * 128 + m * 16) * FF + col0;
                const f32x4 g0 = acc[ai][0][m][0], g1 = acc[ai][0][m][1], u0 = acc[ai][1][m][0], u1 = acc[ai][1][m][1];
                u32x4 w;
                w.x = pk2(silu(g0[0]) * u0[0], silu(g0[1]) * u0[1]); w.y = pk2(silu(g0[2]) * u0[2], silu(g0[3]) * u0[3]);
                w.z = pk2(silu(g1[0]) * u1[0], silu(g1[1]) * u1[1]); w.w = pk2(silu(g1[2]) * u1[2], silu(g1[3]) * u1[3]);
                *(u32x4*)rowp = w;
            }
    }
};
struct EpiResid {
    static constexpr bool PERM = false, AFTER_DRAIN = false;
    const float* X; float* Z; float scale;
    __device__ __forceinline__ void operator()(const f32x4 (&acc)[2][2][4][2], const pg8::Unit& u, int wr, int wc, int fr, int fq) const {
        const int row0 = u.pm * 256 + wr * 64 + fr, col0 = u.pn * 256 + wc * 32 + 4 * fq;
#pragma unroll
        for (int ai = 0; ai < 2; ++ai)
#pragma unroll
            for (int m = 0; m < 4; ++m) {
                const size_t off = (size_t)(row0 + ai * 128 + m * 16) * D + col0;
#pragma unroll
                for (int bj = 0; bj < 2; ++bj)
#pragma unroll
                    for (int n = 0; n < 2; ++n) {
                        const f32x4 xv = *(const f32x4*)(X + off + bj * 128 + n * 16);
                        *(f32x4*)(Z + off + bj * 128 + n * 16) = xv * ALPHA + acc[ai][bj][m][n] * scale;
                    }
            }
    }
};

struct EpiSlab {
    static constexpr bool PERM = false, AFTER_DRAIN = false;
    float* Z;
    __device__ __forceinline__ void operator()(const f32x4 (&acc)[2][2][4][2], const pg8::Unit& u, int wr, int wc, int fr, int fq) const {
        const int row0 = u.pm * 256 + wr * 64 + fr, col0 = u.pn * 256 + wc * 32 + 4 * fq;
#pragma unroll
        for (int ai = 0; ai < 2; ++ai)
#pragma unroll
            for (int m = 0; m < 4; ++m) { const size_t off = (size_t)(row0 + ai * 128 + m * 16) * D + col0;
#pragma unroll
                for (int bj = 0; bj < 2; ++bj)
#pragma unroll
                    for (int n = 0; n < 2; ++n) *(f32x4*)(Z + off + bj * 128 + n * 16) = acc[ai][bj][m][n]; }
    }
};
struct OneUnit {
    int pm, pn; bool has;
    __device__ bool next(int i, pg8::Unit& u) const { if (i != 0 || !has) return false; u.pm = pm; u.pn = pn; return true; }
    __device__ __forceinline__ void a_ready(const pg8::Unit&) const {}
    __device__ __forceinline__ void done(const pg8::Unit&) const {}
};

__device__ __forceinline__ void conv_jobs(const Frame& F, int l0, int l1, int mask, float* tile, int vb, int nvb) {
    const int tid = otid();
#pragma unroll
    for (int jb = 0; jb < 6; ++jb) {
        const int ly = (jb < 3) ? l1 : l0; if (ly < 0 || ly >= DEPTH || !((mask >> jb) & 1)) continue;
        const float* src; bf16_t* dst; int K, N, Npad, mode = 0;
        if (jb == 0)      { src = F.in[8]  + (size_t)ly * D * 2 * FF; dst = F.w1a;  K = D;  N = 2 * FF; Npad = 2 * FF; mode = 1; }
        else if (jb == 1) { src = F.in[9]  + (size_t)ly * FF * D;     dst = F.w1b;  K = FF; N = D;      Npad = D; }
        else if (jb == 2) { src = F.in[12] + (size_t)ly * D * NPROJ;  dst = F.win;  K = D;  N = NPROJ;  Npad = NPP; }
        else if (jb == 3) { src = F.in[30] + (size_t)ly * D * D;      dst = F.wout; K = D;  N = D;      Npad = D; }
        else if (jb == 4) { src = F.in[33] + (size_t)ly * D * 2 * FF; dst = F.w2a;  K = D;  N = 2 * FF; Npad = 2 * FF; mode = 1; }
        else              { src = F.in[34] + (size_t)ly * FF * D;     dst = F.w2b;  K = FF; N = D;      Npad = D; }
        const int tk = K / 64, tn = Npad / 64, nt = tk * tn;
        const int wave = __builtin_amdgcn_readfirstlane(tid >> 6), lane = tid & 63;
        float* wt = tile + wave * (64 * 65);
        for (int t = vb * 8 + wave; t < nt; t += nvb * 8) {
            const int k0 = (t % tk) * 64, n0 = (t / tk) * 64, n = n0 + lane;
            const float* sp = src + (size_t)k0 * N + n;
#pragma unroll 1
            for (int i0 = 0; i0 < 64; i0 += 16) {
                float v[16];
#pragma unroll
                for (int i = 0; i < 16; ++i) v[i] = (n < N) ? sp[(size_t)(i0 + i) * N] : 0.f;
#pragma unroll
                for (int i = 0; i < 16; ++i) wt[(i0 + i) * 65 + lane] = v[i];
            }
            const int kk2 = (lane & 31) * 2;
#pragma unroll 8
            for (int i = 0; i < 32; ++i) { const int nn = (lane >> 5) + 2 * i, n2 = n0 + nn; int nd = n2;
                if (mode) { const int half = n2 / FF, idx = n2 % FF; nd = (idx >> 7) * 256 + half * 128 + (idx & 127); }
                *(unsigned*)(dst + (size_t)nd * K + k0 + kk2) = pk2(wt[kk2 * 65 + nn], wt[(kk2 + 1) * 65 + nn]); }
        }
    }
}

__device__ __forceinline__ void ln_load(const Frame& F, int row, int lane, int nsl, float scale, f32x4 (&v)[4]) {
#pragma unroll
    for (int i = 0; i < 4; ++i) {
        if (row < MP) v[i] = *(const f32x4*)(F.z + (size_t)row * D + i * 256 + lane * 4);
        else { f32x4 a = {0.f, 0.f, 0.f, 0.f}; for (int q = 0; q < nsl; ++q) a += *(const f32x4*)(F.slab + ((size_t)q * MS + (row - MP)) * D + i * 256 + lane * 4);
               v[i] = *(const f32x4*)(F.xf + (size_t)row * D + i * 256 + lane * 4) * ALPHA + a * scale; } }
}
__device__ __forceinline__ void ln_finish(const Frame& F, int row, int lane, const float* __restrict__ g, const float* __restrict__ b, float* out2, f32x4 (&v)[4]) {
    float s = 0.f;
#pragma unroll
    for (int i = 0; i < 4; ++i) s += (v[i][0] + v[i][1]) + (v[i][2] + v[i][3]);
    const float mean = wsum(s) * (1.f / 1024.f); float q = 0.f;
#pragma unroll
    for (int i = 0; i < 4; ++i) { v[i] = v[i] - mean; q += (v[i][0] * v[i][0] + v[i][1] * v[i][1]) + (v[i][2] * v[i][2] + v[i][3] * v[i][3]); }
    const float rstd = rsqrtf(wsum(q) * (1.f / 1024.f) + 1e-5f);
#pragma unroll
    for (int i = 0; i < 4; ++i) { const int c = i * 256 + lane * 4;
        const f32x4 y = v[i] * rstd * *(const f32x4*)(g + c) + *(const f32x4*)(b + c);
        *(f32x4*)(F.xf + (size_t)row * D + c) = y;
        if (out2) *(f32x4*)(out2 + (size_t)row * D + c) = y;
        u32x2 w; w.x = pk2(y[0], y[1]); w.y = pk2(y[2], y[3]); *(u32x2*)(F.xb + (size_t)row * D + c) = w; }
}
__device__ __forceinline__ void ln_phase(const Frame& F, const float* __restrict__ g, const float* __restrict__ b, float* out2, int nsl, float scale) {
    const int tid = otid(), wave = tid >> 6, lane = tid & 63, stride = gridDim.x * 8;
    for (int row = obid() * 8 + wave; row < M; row += 2 * stride) {
        const int row1 = row + stride;
        f32x4 v0[4], v1[4];
        ln_load(F, row, lane, nsl, scale, v0);
        if (row1 < M) ln_load(F, row1, lane, nsl, scale, v1);
        ln_finish(F, row, lane, g, b, out2, v0);
        if (row1 < M) ln_finish(F, row1, lane, g, b, out2, v1);
    }
}

constexpr int RW_STEP = 324, GD_STEP = 136, ROW_REC = 128, NBS = 4;
constexpr int SCAN_BUF_FLOATS = NBS * RW_STEP + NBS * ROW_REC;
constexpr int SCAN_WAVE_FLOATS = 2 * SCAN_BUF_FLOATS + NBS * 64;
#define MK_LAS __attribute__((address_space(3)))
template <bool GDN, bool FULL>
__device__ __forceinline__ void stage_dma(const float* base, const float* rowrec, int nsteps, float* lw, int lane0) {
    constexpr int STEP = GDN ? GD_STEP : RW_STEP, F4 = STEP / 4, NR = GDN ? 3 : 6;
    int lane = lane0; asm volatile("" : "+v"(lane));
    MK_LAS unsigned char* l3 = (MK_LAS unsigned char*)lw;
#pragma unroll
    for (int i = 0; i < NR; ++i) { const int idx = lane + 64 * i, st = idx / F4, wi = idx - st * F4;
        if (FULL ? (idx < NBS * F4) : (st < nsteps)) __builtin_amdgcn_global_load_lds((const unsigned*)(base + (size_t)st * 4 * STEP + wi * 4), (MK_LAS unsigned*)(l3 + i * 1024), 16, 0, 0); }
#pragma unroll
    for (int i = 0; i < 2; ++i) { const int idx = lane + 64 * i, st = idx >> 5, wi = idx & 31;
        if (FULL || st < nsteps) __builtin_amdgcn_global_load_lds((const unsigned*)(rowrec + (size_t)st * 4 * ROW_REC + wi * 4), (MK_LAS unsigned*)(l3 + NBS * RW_STEP * 4 + i * 1024), 16, 0, 0); }
}
#define MK_WAIT_NEXT(GDN) do { if (GDN) asm volatile("s_waitcnt vmcnt(5)" ::: "memory"); else asm volatile("s_waitcnt vmcnt(8)" ::: "memory"); } while (0)

template <bool GDN>
__device__ __forceinline__ void step_pq(f32x2 (&SA)[32], f32x2 (&SB)[32], const float* o, float c) {
    const float* dv = GDN ? o : o + 64;
    f32x2 pa0 = {0.f, 0.f}, pa1 = pa0, pa2 = pa0, pa3 = pa0, qa0 = pa0, qa1 = pa0, qa2 = pa0, qa3 = pa0;
#pragma unroll
    for (int q = 0; q < 16; q += 2) { const f32x4 x = *(const f32x4*)(dv + q * 4), y = *(const f32x4*)(dv + q * 4 + 4);
        const f32x2 x0 = {x[0], x[1]}, x1 = {x[2], x[3]}, y0 = {y[0], y[1]}, y1 = {y[2], y[3]};
        pa0 += SA[2 * q] * x0; pa1 += SA[2 * q + 1] * x1; pa2 += SA[2 * q + 2] * y0; pa3 += SA[2 * q + 3] * y1;
        qa0 += SB[2 * q] * x0; qa1 += SB[2 * q + 1] * x1; qa2 += SB[2 * q + 2] * y0; qa3 += SB[2 * q + 3] * y1; if ((q & 7) == 6) __builtin_amdgcn_sched_barrier(0); }
    const f32x2 pt = (pa0 + pa1) + (pa2 + pa3), qt = (qa0 + qa1) + (qa2 + qa3);
    const float dA = pt.x + pt.y, dB = qt.x + qt.y;
    if (GDN) {
        const float eg = o[128], coef = o[129], uA = coef * dA, uB = coef * dB + c;
        const f32x2 e2 = {eg, eg}, ua2 = {uA, uA}, ub2 = {uB, uB};
#pragma unroll
        for (int q = 0; q < 16; ++q) { const f32x4 k = *(const f32x4*)(o + q * 4); const f32x2 k0 = {k[0], k[1]}, k1 = {k[2], k[3]};
            SA[2 * q] = SA[2 * q] * e2 + ua2 * k0; SA[2 * q + 1] = SA[2 * q + 1] * e2 + ua2 * k1;
            SB[2 * q] = SB[2 * q] * e2 + ub2 * k0; SB[2 * q + 1] = SB[2 * q + 1] * e2 + ub2 * k1; if ((q & 3) == 3) __builtin_amdgcn_sched_barrier(0); }
    } else {
        const f32x2 sa2 = {-dA, -dA}, sb2 = {-dB, -dB}, c2 = {c, c};
#pragma unroll
        for (int q = 0; q < 16; ++q) { const f32x4 w = *(const f32x4*)(o + q * 4), b = *(const f32x4*)(o + 128 + q * 4), k = *(const f32x4*)(o + 192 + q * 4);
            const f32x2 w0 = {w[0], w[1]}, w1 = {w[2], w[3]}, b0 = {b[0], b[1]}, b1 = {b[2], b[3]}, k0 = {k[0], k[1]}, k1 = {k[2], k[3]};
            SA[2 * q] = SA[2 * q] * w0 + sa2 * b0; SA[2 * q + 1] = SA[2 * q + 1] * w1 + sa2 * b1;
            SB[2 * q] = SB[2 * q] * w0 + sb2 * b0 + c2 * k0; SB[2 * q + 1] = SB[2 * q + 1] * w1 + sb2 * b1 + c2 * k1; if ((q & 3) == 3) __builtin_amdgcn_sched_barrier(0); }
    }
}
template <bool GDN>
__device__ __forceinline__ float step_out(f32x2 (&S)[32], const float* o, float c) {
    const float* dv = GDN ? o : o + 64;
    f32x2 a0 = {0.f, 0.f}, a1 = a0, a2 = a0, a3 = a0;
#pragma unroll
    for (int q = 0; q < 16; q += 2) { const f32x4 x = *(const f32x4*)(dv + q * 4), y = *(const f32x4*)(dv + q * 4 + 4);
        a0 += S[2 * q] * (f32x2){x[0], x[1]}; a1 += S[2 * q + 1] * (f32x2){x[2], x[3]}; a2 += S[2 * q + 2] * (f32x2){y[0], y[1]}; a3 += S[2 * q + 3] * (f32x2){y[2], y[3]}; }
    const f32x2 at = (a0 + a1) + (a2 + a3); const float dot = at.x + at.y;
    if (GDN) {
        const float eg = o[128], coef = o[129], u = coef * dot + c; const f32x2 e2 = {eg, eg}, u2 = {u, u};
#pragma unroll
        for (int q = 0; q < 16; ++q) { const f32x4 k = *(const f32x4*)(o + q * 4);
            S[2 * q] = S[2 * q] * e2 + u2 * (f32x2){k[0], k[1]}; S[2 * q + 1] = S[2 * q + 1] * e2 + u2 * (f32x2){k[2], k[3]}; }
    } else {
        const f32x2 sa2 = {-dot, -dot}, c2 = {c, c};
#pragma unroll
        for (int q = 0; q < 16; ++q) { const f32x4 w = *(const f32x4*)(o + q * 4), b = *(const f32x4*)(o + 128 + q * 4), k = *(const f32x4*)(o + 192 + q * 4);
            S[2 * q] = S[2 * q] * (f32x2){w[0], w[1]} + sa2 * (f32x2){b[0], b[1]} + c2 * (f32x2){k[0], k[1]};
            S[2 * q + 1] = S[2 * q + 1] * (f32x2){w[2], w[3]} + sa2 * (f32x2){b[2], b[3]} + c2 * (f32x2){k[2], k[3]}; }
    }
    const float* rv = o + (GDN ? 64 : 256);
    f32x2 y0 = {0.f, 0.f}, y1 = y0, y2 = y0, y3 = y0;
#pragma unroll
    for (int q = 0; q < 16; q += 2) { const f32x4 x = *(const f32x4*)(rv + q * 4), y = *(const f32x4*)(rv + q * 4 + 4);
        y0 += S[2 * q] * (f32x2){x[0], x[1]}; y1 += S[2 * q + 1] * (f32x2){x[2], x[3]}; y2 += S[2 * q + 2] * (f32x2){y[0], y[1]}; y3 += S[2 * q + 3] * (f32x2){y[2], y[3]}; }
    const f32x2 yt = (y0 + y1) + (y2 + y3); return yt.x + yt.y;
}

template <bool GDN>
__device__ __forceinline__ void pass1_item(const Frame& F, int ch, int j, int h, int m0, float* lw, int lane) {
    constexpr int STEP = GDN ? GD_STEP : RW_STEP;
    f32x2 SA[32], SB[32];
#pragma unroll
    for (int i = 0; i < 32; ++i) { SA[i] = (f32x2){(2 * i == lane) ? 1.f : 0.f, (2 * i + 1 == lane) ? 1.f : 0.f}; SB[i] = (f32x2){0.f, 0.f}; }
    const float* ops = (GDN ? F.gdops : F.rwops) + ((size_t)m0 * 4 + h) * STEP;
    const float* rr = (GDN ? F.gdc : F.rwc) + ((size_t)m0 * 4 + h) * ROW_REC;
    stage_dma<GDN, true>(ops, rr, NBS, lw, lane);
    for (int t0 = 0; t0 < CH_L; t0 += NBS) {
        float* cur = lw + ((t0 / NBS) & 1) * SCAN_BUF_FLOATS;
        if (t0 + NBS < CH_L) { stage_dma<GDN, true>(ops + (size_t)(t0 + NBS) * 4 * STEP, rr + (size_t)(t0 + NBS) * 4 * ROW_REC, NBS, lw + (((t0 / NBS) + 1) & 1) * SCAN_BUF_FLOATS, lane); MK_WAIT_NEXT(GDN); }
        else asm volatile("s_waitcnt vmcnt(0)" ::: "memory");
#pragma unroll 1
        for (int e = 0; e < NBS; ++e) step_pq<GDN>(SA, SB, cur + e * STEP, cur[NBS * RW_STEP + e * ROW_REC + lane]);
    }
    float* o = F.pq + ((size_t)(ch * NCH + j) * 2) * 4096 + lane * 64;
#pragma unroll
    for (int i = 0; i < 16; ++i) { *(f32x4*)(o + i * 4) = (f32x4){SA[2 * i].x, SA[2 * i].y, SA[2 * i + 1].x, SA[2 * i + 1].y};
        *(f32x4*)(o + 4096 + i * 4) = (f32x4){SB[2 * i].x, SB[2 * i].y, SB[2 * i + 1].x, SB[2 * i + 1].y}; }
}
__device__ __forceinline__ void scan_pass1(const Frame& F, float* ldsf) {
    const int tid = otid(), wave = __builtin_amdgcn_readfirstlane(tid >> 6), lane = tid & 63, G = gridDim.x;
    float* lw = ldsf + wave * SCAN_WAVE_FLOATS;
    for (int it = wave * G + obid(); it < 32 * NCH; it += 8 * G) {
        const int j = it % NCH, c2 = it / NCH, b = c2 & 3, h8 = c2 >> 2, ch = b * 8 + h8, m0 = b * SEQ + j * CH_L;
        if (h8 < 4) pass1_item<false>(F, ch, j, h8, m0, lw, lane); else pass1_item<true>(F, ch, j, h8 - 4, m0, lw, lane);
    }
}

template <bool GDN, bool FULL>
__device__ __forceinline__ void out_item(const Frame& F, int l, f32x2 (&S)[32], int h, int m0, int nsteps, float* lw, int lane) {
    constexpr int STEP = GDN ? GD_STEP : RW_STEP;
    const float* ops = (GDN ? F.gdops : F.rwops) + ((size_t)m0 * 4 + h) * STEP;
    const float* rr = (GDN ? F.gdc : F.rwc) + ((size_t)m0 * 4 + h) * ROW_REC;
    const float gng = GDN ? 0.f : F.in[22][l * 256 + h * 64 + lane], gnb = GDN ? 0.f : F.in[23][l * 256 + h * 64 + lane];
    bf16_t* mixp = F.mix + (size_t)m0 * D + (GDN ? 768 : 0) + h * 64 + lane;
    float* yl = lw + 2 * SCAN_BUF_FLOATS;
    stage_dma<GDN, FULL>(ops, rr, nsteps < NBS ? nsteps : NBS, lw, lane);
    for (int t0 = 0; t0 < nsteps; t0 += NBS) {
        float* cur = lw + ((t0 / NBS) & 1) * SCAN_BUF_FLOATS;
        const int nb = FULL ? NBS : ((nsteps - t0 < NBS) ? nsteps - t0 : NBS);
        if (t0 + NBS < nsteps) { stage_dma<GDN, true>(ops + (size_t)(t0 + NBS) * 4 * STEP, rr + (size_t)(t0 + NBS) * 4 * ROW_REC, NBS, lw + (((t0 / NBS) + 1) & 1) * SCAN_BUF_FLOATS, lane); MK_WAIT_NEXT(GDN); }
        else asm volatile("s_waitcnt vmcnt(0)" ::: "memory");
#pragma unroll 1
        for (int e = 0; e < nb; ++e) yl[e * 64 + lane] = step_out<GDN>(S, cur + e * STEP, cur[NBS * RW_STEP + e * ROW_REC + lane]);
#pragma unroll
        for (int e = 0; e < NBS; ++e) if (e < nb) { const float y = yl[e * 64 + lane]; const float* rw = cur + NBS * RW_STEP + e * ROW_REC; float o;
            if (GDN) { const float ms = wsum(y * y) * (1.f / 64.f); o = y * rsqrtf(ms + 1e-6f) * rw[64 + lane]; }
            else { const float mean = wsum(y) * (1.f / 64.f), d = y - mean, var = wsum(d * d) * (1.f / 64.f);
                   o = (d * rsqrtf(var + 64e-5f) * gng + gnb + cur[e * STEP + 320] * rw[lane]) * rw[64 + lane]; }
            mixp[(size_t)(t0 + e) * D] = f2bf(o); }
    }
}
__device__ __forceinline__ void scan_pass3(const Frame& F, int l, float* ldsf) {
    const int tid = otid(), wave = __builtin_amdgcn_readfirstlane(tid >> 6), lane = tid & 63, G = gridDim.x;
    float* lw = ldsf + wave * SCAN_WAVE_FLOATS;
    for (int it = wave * G + obid(); it < 32 * NCH; it += 8 * G) {
        const int j = it % NCH, c2 = it / NCH, b = c2 & 3, h8 = c2 >> 2, ch = b * 8 + h8, m0 = b * SEQ + j * CH_L;
        f32x2 S[32];
        const float* s0 = F.sst + ((size_t)(ch * NCH + j) * 64 + lane) * 64;
#pragma unroll
        for (int i = 0; i < 16; ++i) { const f32x4 v = *(const f32x4*)(s0 + i * 4); S[2 * i] = (f32x2){v[0], v[1]}; S[2 * i + 1] = (f32x2){v[2], v[3]}; }
        if (h8 < 4) out_item<false, true>(F, l, S, h8, m0, CH_L, lw, lane); else out_item<true, true>(F, l, S, h8 - 4, m0, CH_L, lw, lane);
    }
}
__device__ __forceinline__ void scan_sample(const Frame& F, int l, int vb, int nvb, float* ldsf) {
    const int tid = otid(), wave = __builtin_amdgcn_readfirstlane(tid >> 6), lane = tid & 63;
    float* lw = ldsf + wave * SCAN_WAVE_FLOATS;
    for (int it = wave * nvb + vb; it < 128 * 8; it += 8 * nvb) {
        const int b = it & 127, h8 = it >> 7, m0 = MP + b * 4;
        f32x2 S[32];
        if (h8 < 4) {
            const size_t so = ((size_t)((l * 128 + b) * 4 + h8) * 64 + lane) * 64;
            const float* s0 = F.in[2] + so;
#pragma unroll
            for (int i = 0; i < 16; ++i) { const f32x4 v = *(const f32x4*)(s0 + i * 4); S[2 * i] = (f32x2){v[0], v[1]}; S[2 * i + 1] = (f32x2){v[2], v[3]}; }
            out_item<false, false>(F, l, S, h8, m0, 4, lw, lane);
            float* o = F.out + O_SRW + so;
#pragma unroll
            for (int i = 0; i < 16; ++i) *(f32x4*)(o + i * 4) = (f32x4){S[2 * i].x, S[2 * i].y, S[2 * i + 1].x, S[2 * i + 1].y};
        } else {
            const int h = h8 - 4;
            const size_t so = (size_t)((l * 128 + b) * 4 + h) * 4096 + lane;
            const float* s0 = F.in[6] + so;
#pragma unroll
            for (int i = 0; i < 32; ++i) S[i] = (f32x2){s0[(2 * i) * 64], s0[(2 * i + 1) * 64]};
            out_item<true, false>(F, l, S, h, m0, 4, lw, lane);
            float* o = F.out + O_SGD + so;
#pragma unroll
            for (int i = 0; i < 32; ++i) { o[(2 * i) * 64] = S[i].x; o[(2 * i + 1) * 64] = S[i].y; }
        }
    }
}

__device__ __forceinline__ float fexp(float x) { return __expf(x); }
__device__ __forceinline__ float fsoftplus(float x) { return (x > 20.f) ? x : __logf(1.f + __expf(x)); }
__device__ __forceinline__ float ftanh(float x) { return 1.f - 2.f * __builtin_amdgcn_rcpf(__expf(2.f * x) + 1.f); }
__device__ __forceinline__ void pre_a(const Frame& F, int l) {
    const unsigned gt = (unsigned)obid() * 512u + (unsigned)otid(), gs = gridDim.x * 512u;
    const float* mu = F.in[13] + l * 896;
    for (unsigned i = gt; i < (unsigned)M * 128u; i += gs) { const int m = i >> 7, p = i & 127; unsigned w = 0u;
        if (p < 64) { const int col = 768 + 2 * p;
            const bool samp = m >= MP; const int b = samp ? ((m - MP) >> 2) : (m >> 12), t = samp ? ((m - MP) & 3) : (m & 4095);
            const bf16_t* row = F.proj + (size_t)m * NPP;
            const unsigned fw = *(const unsigned*)(row + col); const float f0 = __uint_as_float(fw << 16), f1 = __uint_as_float(fw & 0xffff0000u);
            float p0 = 0.f, p1 = 0.f;
            if (t > 0) { const unsigned pw = *(const unsigned*)(row + col - NPP); p0 = __uint_as_float(pw << 16); p1 = __uint_as_float(pw & 0xffff0000u); }
            else if (samp) { const float* sp = F.in[3] + (size_t)(l * 128 + b) * 896 + col; p0 = sp[0]; p1 = sp[1]; }
            float a0 = f0 + (p0 - f0) * mu[col], a1 = f1 + (p1 - f1) * mu[col + 1];
            if (p < 16) { a0 = ftanh(a0); a1 = ftanh(a1); } else if (p >= 32) { a0 = sigm(a0); a1 = sigm(a1); }
            w = pk2(a0, a1); }
        ((unsigned*)F.li)[i] = w; }
}
__device__ __forceinline__ void conv_lora(const Frame& F) {
    const unsigned gt = (unsigned)obid() * 512u + (unsigned)otid(), gs = gridDim.x * 512u;
    for (unsigned i = gt; i < (unsigned)DEPTH * 768u * 256u; i += gs) { const int k = i & 255, n = (i >> 8) % 768, l = i / (768u * 256u); float v = 0.f;
        if (n < 256) { if (k < 32) v = F.in[15][(l * 32 + k) * 256 + n]; }
        else if (n < 512) { if (k >= 32 && k < 64) v = F.in[17][(l * 32 + k - 32) * 256 + n - 256]; }
        else { if (k >= 64 && k < 128) v = F.in[18][(l * 64 + k - 64) * 256 + n - 512]; }
        F.wl[i] = f2bf(v); }
}
template <bool ST>
__device__ __forceinline__ void pre_b(const Frame& F, int l) {
    constexpr int TBB = 3;
    const int tid = otid(), wave = __builtin_amdgcn_readfirstlane(tid >> 6), lane = tid & 63, G = gridDim.x;
    const int per = (M + G - 1) / G, mlo = obid() * per, mhi = (mlo + per < M) ? mlo + per : M;
    if (wave < 4) {
        const int h = wave, c = h * 64 + lane;
        const float* mu = F.in[13] + l * 896;
        const float mu_r = mu[c], mu_k = mu[256 + c], mu_v = mu[512 + c], w0c = F.in[14][l * 256 + c], a0c = F.in[16][l * 256 + c];
        const float kkc = F.in[19][l * 256 + c], kac = F.in[20][l * 256 + c], rkc = F.in[21][l * 256 + c];
        for (int mb = mlo; mb < mhi; mb += TBB) {
            float xr[TBB], xk[TBB], xv[TBB], dw[TBB], da[TBB], dg[TBB];
            const bool fastp = (mb + TBB <= mhi) && (mb + TBB <= MP) && ((mb & 4095) >= 1) && ((mb & 4095) + TBB <= 4096);
            if (fastp) {
#pragma unroll
                for (int e = 0; e < TBB; ++e) { const int m = mb + e;
                    const bf16_t* row = F.proj + (size_t)m * NPP;
                    const float f_r = bf2f(row[c]), f_k = bf2f(row[256 + c]), f_v = bf2f(row[512 + c]);
                    const float p_r = bf2f(row[c - NPP]), p_k = bf2f(row[256 + c - NPP]), p_v = bf2f(row[512 + c - NPP]);
                    xr[e] = f_r + (p_r - f_r) * mu_r; xk[e] = f_k + (p_k - f_k) * mu_k; xv[e] = f_v + (p_v - f_v) * mu_v;
                    const float* dt = F.dots + (size_t)m * 768; dw[e] = dt[c]; da[e] = dt[256 + c]; dg[e] = dt[512 + c]; }
            } else {
#pragma unroll
            for (int e = 0; e < TBB; ++e) { const int m = mb + e; xr[e] = 0.f; xk[e] = 0.f; xv[e] = 0.f; dw[e] = 0.f; da[e] = 0.f; dg[e] = 0.f;
                if (m < mhi) {
                    const bool samp = m >= MP; const int b = samp ? ((m - MP) >> 2) : (m >> 12), t = samp ? ((m - MP) & 3) : (m & 4095);
                    const bf16_t* row = F.proj + (size_t)m * NPP; const float* shp = F.in[3] + (size_t)(l * 128 + b) * 896;
                    const float f_r = bf2f(row[c]), f_k = bf2f(row[256 + c]), f_v = bf2f(row[512 + c]);
                    float p_r = 0.f, p_k = 0.f, p_v = 0.f;
                    if (t > 0) { p_r = bf2f(row[c - NPP]); p_k = bf2f(row[256 + c - NPP]); p_v = bf2f(row[512 + c - NPP]); }
                    else if (samp) { p_r = shp[c]; p_k = shp[256 + c]; p_v = shp[512 + c]; }
                    xr[e] = f_r + (p_r - f_r) * mu_r; xk[e] = f_k + (p_k - f_k) * mu_k; xv[e] = f_v + (p_v - f_v) * mu_v;
                    const float* dt = F.dots + (size_t)m * 768; dw[e] = dt[c]; da[e] = dt[256 + c]; dg[e] = dt[512 + c]; } }
            }
#pragma unroll
            for (int e = 0; e < TBB; ++e) { const int m = mb + e;
                if (m < mhi) {
                    const float r = xr[e], k = xk[e], v = xv[e];
                    const float wl = -fsoftplus(-(w0c + dw[e])) - 0.5f, decay = fexp(-fexp(wl));
                    const float a = sigm(a0c + da[e]);
                    const float kkr = k * kkc, ss = wsum(kkr * kkr), kk = kkr * rsqrtf(ss + 1e-6f);
                    const float k2 = k * (1.f + (a - 1.f) * kac);
                    const float bon = wsum(r * k2 * rkc);
                    float* ops = F.rwops + ((size_t)m * 4 + h) * RW_STEP;
                    if (!ST) { if (decay + kk + k2 + bon == 1234.5f) ops[lane] = 0.f; } else {
                    ops[lane] = decay; ops[64 + lane] = kk; ops[128 + lane] = kk * a; ops[192 + lane] = k2; ops[256 + lane] = r;
                    if (lane < 4) ops[320 + lane] = (lane == 0) ? bon : 0.f;
                    float* rr = F.rwc + ((size_t)m * 4 + h) * ROW_REC; rr[lane] = v; rr[64 + lane] = dg[e]; } } }
        }
    } else {
        const int h = wave - 4, c = h * 64 + lane;
        float cw[4][3];
#pragma unroll
        for (int j = 0; j < 4; ++j)
#pragma unroll
            for (int p = 0; p < 3; ++p) cw[j][p] = F.in[26][(l * 4 + j) * 768 + p * 256 + c];
        const float nalog = -fexp(F.in[27][l * 4 + h]), dtb = F.in[28][l * 4 + h], ng = F.in[29][l * 64 + lane];
        for (int mb = mlo; mb < mhi; mb += TBB) {
            float cv[TBB][3], bl[TBB], al[TBB], zz[TBB];
            const bool fastp = (mb + TBB <= mhi) && (mb + TBB <= MP) && ((mb & 4095) >= 3) && ((mb & 4095) + TBB <= 4096);
            if (fastp) {
#pragma unroll
                for (int e = 0; e < TBB; ++e) { const int m = mb + e;
                    const bf16_t* row = F.proj + (size_t)m * NPP;
#pragma unroll
                    for (int p = 0; p < 3; ++p) { const int chn = p * 256 + c; float acc = 0.f;
#pragma unroll
                        for (int j = 0; j < 4; ++j) acc += bf2f(row[GO + chn - (3 - j) * NPP]) * cw[j][p];
                        cv[e][p] = acc; }
                    bl[e] = bf2f(row[GO + 1024 + h]); al[e] = bf2f(row[GO + 1028 + h]); zz[e] = bf2f(row[GO + 768 + c]); }
            } else {
#pragma unroll
            for (int e = 0; e < TBB; ++e) { const int m = mb + e; cv[e][0] = 0.f; cv[e][1] = 0.f; cv[e][2] = 0.f; bl[e] = 0.f; al[e] = 0.f; zz[e] = 0.f;
                if (m < mhi) {
                    const bool samp = m >= MP; const int b = samp ? ((m - MP) >> 2) : (m >> 12), t = samp ? ((m - MP) & 3) : (m & 4095);
                    const bf16_t* row = F.proj + (size_t)m * NPP;
#pragma unroll
                    for (int p = 0; p < 3; ++p) { const int chn = p * 256 + c; float acc = 0.f;
#pragma unroll
                        for (int j = 0; j < 4; ++j) { const int back = 3 - j; float x;
                            if (t - back >= 0) x = bf2f(row[GO + chn - back * NPP]);
                            else x = samp ? F.in[7][((size_t)(l * 128 + b) * 3 + (t - back + 3)) * 768 + chn] : 0.f;
                            acc += x * cw[j][p]; }
                        cv[e][p] = acc; }
                    bl[e] = bf2f(row[GO + 1024 + h]); al[e] = bf2f(row[GO + 1028 + h]); zz[e] = bf2f(row[GO + 768 + c]); } }
            }
#pragma unroll
            for (int e = 0; e < TBB; ++e) { const int m = mb + e;
                if (m < mhi) {
                    const float q = silu(cv[e][0]), k = silu(cv[e][1]), v = silu(cv[e][2]);
                    const float qs = wsum(q * q), ks = wsum(k * k);
                    const float qn = q * rsqrtf(qs + 1e-6f) * 0.125f, kn = k * rsqrtf(ks + 1e-6f);
                    const float beta = sigm(bl[e]), gg = nalog * fsoftplus(al[e] + dtb), eg = fexp(gg);
                    float* gops = F.gdops + ((size_t)m * 4 + h) * GD_STEP;
                    if (!ST) { if (kn + qn + eg + v == 1234.5f) gops[lane] = 0.f; } else {
                    gops[lane] = kn; gops[64 + lane] = qn;
                    if (lane < 8) gops[128 + lane] = (lane == 0) ? eg : ((lane == 1) ? -beta * eg : 0.f);
                    float* rr = F.gdc + ((size_t)m * 4 + h) * ROW_REC; rr[lane] = beta * v; rr[64 + lane] = ng * silu(zz[e]); } } }
        }
    }
}

__device__ __forceinline__ void split8(const f32x4 x0, const f32x4 x1, bf16x8& hi, bf16x8& lo) {
    u32x4 h, l; float r[8] = {x0[0], x0[1], x0[2], x0[3], x1[0], x1[1], x1[2], x1[3]};
    unsigned hw[4], lw[4];
#pragma unroll
    for (int i = 0; i < 4; ++i) { hw[i] = pk2(r[2 * i], r[2 * i + 1]);
        const float d0 = r[2 * i] - __uint_as_float(hw[i] << 16), d1 = r[2 * i + 1] - __uint_as_float(hw[i] & 0xffff0000u); lw[i] = pk2(d0, d1); }
    h = (u32x4){hw[0], hw[1], hw[2], hw[3]}; l = (u32x4){lw[0], lw[1], lw[2], lw[3]};
    hi = __builtin_bit_cast(bf16x8, h); lo = __builtin_bit_cast(bf16x8, l);
}
__device__ __forceinline__ void chain_store_p(bf16_t* Pt, int tid, const f32x4 (&pn)[2]) {
#pragma unroll
    for (int e = 0; e < 2; ++e) { const int idx = tid + 512 * e, i = idx >> 4, kc0 = (idx & 15) * 4;
#pragma unroll
        for (int c = 0; c < 4; ++c) { const float x = pn[e][c]; const unsigned hw = pk2(x, x) & 0xffffu; const float d = x - __uint_as_float(hw << 16);
            Pt[(kc0 + c) * 72 + i] = (bf16_t)hw; Pt[4608 + (kc0 + c) * 72 + i] = f2bf(d); } }
}
__device__ __forceinline__ void chain_prop(const Frame& F, int l, int ch, float* lds) {
    const int tid = otid(), wave = tid >> 6, lane = tid & 63, fr = lane & 15, gq = lane >> 4, b = ch >> 3, h8 = ch & 7;
    float* Sl = lds; bf16_t* Pb = (bf16_t*)(lds + 64 * 68);
    const int tr = wave >> 1, tc0 = (wave & 1) * 2;
    for (int i = tid; i < 64 * 68; i += 512) Sl[i] = 0.f;
    { float* s0 = F.sst + (size_t)(ch * NCH) * 4096; for (int i = tid; i < 1024; i += 512) *(f32x4*)(s0 + i * 4) = (f32x4){0.f, 0.f, 0.f, 0.f}; }
    { const float* pg = F.pq + (size_t)(ch * NCH) * 2 * 4096; f32x4 pn[2];
#pragma unroll
      for (int e = 0; e < 2; ++e) pn[e] = *(const f32x4*)(pg + (tid + 512 * e) * 4);
      chain_store_p(Pb, tid, pn); }
    f32x4 qn[2];
    { const float* Qg = F.pq + ((size_t)(ch * NCH) * 2 + 1) * 4096;
#pragma unroll
      for (int tt = 0; tt < 2; ++tt)
#pragma unroll
        for (int r = 0; r < 4; ++r) qn[tt][r] = Qg[(16 * tr + 4 * gq + r) * 64 + 16 * (tc0 + tt) + fr]; }
    __syncthreads();
    for (int j = 0; j < NCH; ++j) {
        const bf16_t* Pj = Pb + (j & 1) * 9216;
        f32x4 pn[2] = {{0.f, 0.f, 0.f, 0.f}, {0.f, 0.f, 0.f, 0.f}};
        f32x4 acc[2] = {qn[0], qn[1]};
        if (j + 1 < NCH) { const float* pg = F.pq + ((size_t)(ch * NCH + j + 1) * 2) * 4096;
#pragma unroll
            for (int e = 0; e < 2; ++e) pn[e] = *(const f32x4*)(pg + (tid + 512 * e) * 4);
            const float* Qg = pg + 4096;
#pragma unroll
            for (int tt = 0; tt < 2; ++tt)
#pragma unroll
                for (int r = 0; r < 4; ++r) qn[tt][r] = Qg[(16 * tr + 4 * gq + r) * 64 + 16 * (tc0 + tt) + fr]; }
#pragma unroll
        for (int ks = 0; ks < 2; ++ks) {
            const float* ar = Sl + (16 * tr + fr) * 68 + ks * 32 + gq * 8;
            bf16x8 ahi, alo; split8(*(const f32x4*)ar, *(const f32x4*)(ar + 4), ahi, alo);
#pragma unroll
            for (int tt = 0; tt < 2; ++tt) { const bf16_t* br = Pj + (16 * (tc0 + tt) + fr) * 72 + ks * 32 + gq * 8;
                const bf16x8 bhi = *(const bf16x8*)br, blo = *(const bf16x8*)(br + 4608);
                acc[tt] = __builtin_amdgcn_mfma_f32_16x16x32_bf16(ahi, bhi, acc[tt], 0, 0, 0);
                acc[tt] = __builtin_amdgcn_mfma_f32_16x16x32_bf16(alo, bhi, acc[tt], 0, 0, 0);
                acc[tt] = __builtin_amdgcn_mfma_f32_16x16x32_bf16(ahi, blo, acc[tt], 0, 0, 0); }
        }
        if (j + 1 < NCH) chain_store_p(Pb + ((j + 1) & 1) * 9216, tid, pn);
        __syncthreads();
#pragma unroll
        for (int tt = 0; tt < 2; ++tt)
#pragma unroll
            for (int r = 0; r < 4; ++r) { const int v = 16 * tr + 4 * gq + r, k = 16 * (tc0 + tt) + fr; const float x = acc[tt][r];
                Sl[v * 68 + k] = x;
                if (j + 1 < NCH) F.sst[(size_t)(ch * NCH + j + 1) * 4096 + v * 64 + k] = x;
                else if (h8 < 4) F.out[O_PRW + (size_t)((l * 4 + b) * 4 + h8) * 4096 + v * 64 + k] = x;
                else F.out[O_PGD + (size_t)((l * 4 + b) * 4 + (h8 - 4)) * 4096 + k * 64 + v] = x; }
        __syncthreads();
    }
}

__device__ __forceinline__ void copy_states(const Frame& F, int l) {
    const unsigned gt = (unsigned)obid() * 512u + (unsigned)otid(), gs = gridDim.x * 512u;
    const bf16_t* P = F.proj;
    for (unsigned i = gt; i < 4u * 896u; i += gs) { const unsigned b = i / 896u, c = i - b * 896u; F.out[O_PRS + (size_t)(l * 4 + b) * 896 + c] = bf2f(P[(size_t)(b * SEQ + SEQ - 1) * NPP + c]); }
    for (unsigned i = gt; i < 128u * 896u; i += gs) { const unsigned b = i / 896u, c = i - b * 896u; F.out[O_SRS + (size_t)(l * 128 + b) * 896 + c] = bf2f(P[(size_t)(MP + 4 * b + 3) * NPP + c]); }
    for (unsigned i = gt; i < 4u * 2304u; i += gs) { const unsigned b = i / 2304u, r = i - b * 2304u, j = r / 768u, c = r - j * 768u; F.out[O_PGC + (size_t)(l * 4 + b) * 2304 + r] = bf2f(P[(size_t)(b * SEQ + SEQ - 3 + j) * NPP + GO + c]); }
    for (unsigned i = gt; i < 128u * 2304u; i += gs) { const unsigned b = i / 2304u, r = i - b * 2304u, j = r / 768u, c = r - j * 768u; F.out[O_SGC + (size_t)(l * 128 + b) * 2304 + r] = bf2f(P[(size_t)(MP + 4 * b + 1 + j) * NPP + GO + c]); }
    for (unsigned i = gt; i < 4u * 128u * 128u; i += gs) { const unsigned c = i & 127u, w = (i >> 7) & 127u, b = i >> 14; const size_t r = (size_t)(b * SEQ + SEQ - 128 + w) * NPP + SO;
        F.out[O_PSK + (size_t)(l * 4 + b) * 16384 + w * 128 + c] = bf2f(P[r + 512 + c]); F.out[O_PSV + (size_t)(l * 4 + b) * 16384 + w * 128 + c] = bf2f(P[r + 640 + c]); }
    for (unsigned i = gt; i < 128u * 128u * 32u; i += gs) { const unsigned c4 = i & 31u, w = (i >> 5) & 127u, b = i >> 12; f32x4 kx, vx;
        if (w < 124u) { const size_t s = ((size_t)(l * 128 + b) * 128 + w + 4) * 128 + c4 * 4; kx = *(const f32x4*)(F.in[4] + s); vx = *(const f32x4*)(F.in[5] + s); }
        else { const bf16_t* r = P + (size_t)(MP + 4 * b + w - 124) * NPP + SO + 512 + c4 * 4; const u32x2 kw = *(const u32x2*)r, vw = *(const u32x2*)(r + 128);
            kx = (f32x4){__uint_as_float(kw.x << 16), __uint_as_float(kw.x & 0xffff0000u), __uint_as_float(kw.y << 16), __uint_as_float(kw.y & 0xffff0000u)};
            vx = (f32x4){__uint_as_float(vw.x << 16), __uint_as_float(vw.x & 0xffff0000u), __uint_as_float(vw.y << 16), __uint_as_float(vw.y & 0xffff0000u)}; }
        const size_t o = (size_t)(l * 128 + b) * 16384 + w * 128 + c4 * 4;
        *(f32x4*)(F.out + O_SSK + o) = kx; *(f32x4*)(F.out + O_SSV + o) = vx; }
}

constexpr int SWA_KP = 72, SWA_VP = 280, SWA_KS_BYTES = 272 * SWA_KP * 2, SWA_VT_BYTES = 64 * SWA_VP * 2;
__device__ const unsigned char REL_BUCKET[128] = {0,1,2,3,4,5,6,7,8,9,10,11,12,13,14,15,16,16,16,17,17,18,18,18,19,19,19,20,20,20,20,21,21,21,21,22,22,22,22,22,23,23,23,23,23,23,24,24,24,24,24,24,25,25,25,25,25,25,25,26,26,26,26,26,26,26,26,27,27,27,27,27,27,27,27,27,27,28,28,28,28,28,28,28,28,28,28,29,29,29,29,29,29,29,29,29,29,29,29,30,30,30,30,30,30,30,30,30,30,30,30,30,30,31,31,31,31,31,31,31,31,31,31,31,31,31,31,31};

__device__ __forceinline__ void swa_core(const bf16_t* Ks, const bf16_t* Vt, const float* biasl, int t0, bf16x8 qf0, bf16x8 qf1, int qpos, int g, int minkey, float sink, f32x4 (&o)[4]) {
    const int lane = otid() & 63, fr = lane & 15, gq = lane >> 4;
    f32x4 s[10];
#pragma unroll
    for (int ti = 0; ti < 10; ++ti) {
        const bf16_t* kr = Ks + ((t0 + ti) * 16 + fr) * SWA_KP + gq * 8;
        const bf16x8 a0 = *(const bf16x8*)kr, a1 = *(const bf16x8*)(kr + 32);
        f32x4 acc = {0.f, 0.f, 0.f, 0.f};
        acc = __builtin_amdgcn_mfma_f32_16x16x32_bf16(a0, qf0, acc, 0, 0, 0);
        acc = __builtin_amdgcn_mfma_f32_16x16x32_bf16(a1, qf1, acc, 0, 0, 0);
        s[ti] = acc;
    }
    float mx = sink;
#pragma unroll
    for (int ti = 0; ti < 10; ++ti)
#pragma unroll
        for (int j = 0; j < 4; ++j) { const int kl = (t0 + ti) * 16 + gq * 4 + j, dist = qpos - kl; const bool ok = (dist >= 0) && (dist < 128) && (kl >= minkey);
            const float v = ok ? s[ti][j] * 0.125f + biasl[(ok ? dist : 0) * 4 + g] : -INFINITY; s[ti][j] = v; mx = fmaxf(mx, v); }
    mx = fmaxf(mx, __shfl_xor(mx, 16)); mx = fmaxf(mx, __shfl_xor(mx, 32));
    float lsum = 0.f;
#pragma unroll
    for (int ti = 0; ti < 10; ++ti)
#pragma unroll
        for (int j = 0; j < 4; ++j) { const float p = __expf(s[ti][j] - mx); s[ti][j] = p; lsum += p; }
    lsum += __shfl_xor(lsum, 16); lsum += __shfl_xor(lsum, 32); lsum += __expf(sink - mx);
    const float inv = 1.f / lsum;
#pragma unroll
    for (int dt = 0; dt < 4; ++dt) o[dt] = (f32x4){0.f, 0.f, 0.f, 0.f};
#pragma unroll
    for (int st = 0; st < 5; ++st) {
        u32x4 pw; pw.x = pk2(s[2 * st][0], s[2 * st][1]); pw.y = pk2(s[2 * st][2], s[2 * st][3]); pw.z = pk2(s[2 * st + 1][0], s[2 * st + 1][1]); pw.w = pk2(s[2 * st + 1][2], s[2 * st + 1][3]);
        const bf16x8 pb = __builtin_bit_cast(bf16x8, pw);
        const int k0 = (t0 + 2 * st) * 16 + gq * 4, k1 = k0 + 16;
#pragma unroll
        for (int dt = 0; dt < 4; ++dt) {
            const bf16_t* vr = Vt + (dt * 16 + fr) * SWA_VP;
            const u32x2 lo = *(const u32x2*)(vr + k0), hi = *(const u32x2*)(vr + k1);
            const u32x4 aw = {lo.x, lo.y, hi.x, hi.y};
            o[dt] = __builtin_amdgcn_mfma_f32_16x16x32_bf16(__builtin_bit_cast(bf16x8, aw), pb, o[dt], 0, 0, 0);
        }
    }
#pragma unroll
    for (int dt = 0; dt < 4; ++dt) o[dt] = o[dt] * inv;
}

__device__ __forceinline__ void swa_bias_fill(const Frame& F, int kvh, float* biasl) {
    const int tid = otid();
    { const int dist = tid >> 2, g = tid & 3; biasl[tid] = F.in[25][REL_BUCKET[dist] * 8 + kvh * 4 + g]; }
}

__device__ __forceinline__ void swa_prompt_item(const Frame& F, int l, int item, unsigned char* lds) {
    bf16_t* Ks = (bf16_t*)lds; bf16_t* Vt = (bf16_t*)(lds + SWA_KS_BYTES); float* biasl = (float*)(lds + SWA_KS_BYTES + SWA_VT_BYTES);
    const int tid = otid(), wave = tid >> 6, lane = tid & 63, fr = lane & 15, gq = lane >> 4;
    const int kvh = item & 1, qt = (item >> 1) & 31, b = item >> 6;
    const int T0 = qt * 128 - 144;
    __syncthreads();
    swa_bias_fill(F, kvh, biasl);
    for (int e = tid; e < 272 * 8; e += 512) { const int i = e >> 3, d8 = e & 7, tk = T0 + i;
        u32x4 kw = {0u, 0u, 0u, 0u}, vw = {0u, 0u, 0u, 0u};
        if (tk >= 0) { const bf16_t* r = F.proj + (size_t)(b * SEQ + tk) * NPP + SO + 512 + kvh * 64 + d8 * 8; kw = *(const u32x4*)r; vw = *(const u32x4*)(r + 128); }
        *(u32x4*)(Ks + i * SWA_KP + d8 * 8) = kw;
        bf16_t* vd = Vt + (d8 * 8) * SWA_VP + i;
        vd[0] = (bf16_t)(vw.x & 0xffff); vd[SWA_VP] = (bf16_t)(vw.x >> 16); vd[2 * SWA_VP] = (bf16_t)(vw.y & 0xffff); vd[3 * SWA_VP] = (bf16_t)(vw.y >> 16);
        vd[4 * SWA_VP] = (bf16_t)(vw.z & 0xffff); vd[5 * SWA_VP] = (bf16_t)(vw.z >> 16); vd[6 * SWA_VP] = (bf16_t)(vw.w & 0xffff); vd[7 * SWA_VP] = (bf16_t)(vw.w >> 16); }
    __syncthreads();
    const int g = wave & 3, half = wave >> 2, head = kvh * 4 + g;
    const float sink = F.in[24][l * 8 + head];
    int minkey = 144 - qt * 128; if (minkey < 0) minkey = 0;
    for (int st = 0; st < 4; ++st) {
        const int ql = half * 64 + st * 16;
        const int m = b * SEQ + qt * 128 + ql + fr;
        const bf16_t* qr = F.proj + (size_t)m * NPP + SO + head * 64 + gq * 8;
        const bf16x8 qf0 = *(const bf16x8*)qr, qf1 = *(const bf16x8*)(qr + 32);
        f32x4 o[4];
        swa_core(Ks, Vt, biasl, half * 4 + st, qf0, qf1, 144 + ql + fr, g, minkey, sink, o);
        bf16_t* op = F.mix + (size_t)m * D + 256 + head * 64 + gq * 4;
#pragma unroll
        for (int dt = 0; dt < 4; ++dt) { u32x2 w; w.x = pk2(o[dt][0], o[dt][1]); w.y = pk2(o[dt][2], o[dt][3]); *(u32x2*)(op + dt * 16) = w; }
    }
}

__device__ __forceinline__ void swa_sample_item(const Frame& F, int l, int item, unsigned char* lds) {
    bf16_t* Ks = (bf16_t*)lds; bf16_t* Vt = (bf16_t*)(lds + SWA_KS_BYTES); float* biasl = (float*)(lds + SWA_KS_BYTES + SWA_VT_BYTES);
    const int tid = otid(), wave = tid >> 6, lane = tid & 63, fr = lane & 15, gq = lane >> 4;
    const int kvh = item & 1, b = item >> 1;
    __syncthreads();
    swa_bias_fill(F, kvh, biasl);
    for (int e = tid; e < 160 * 64; e += 512) { const int i = e >> 6, d = e & 63; float kx = 0.f, vx = 0.f;
        if (i < 128) { const size_t s = ((size_t)(l * 128 + b) * 128 + i) * 128 + kvh * 64 + d; kx = F.in[4][s]; vx = F.in[5][s]; }
        else if (i < 132) { const bf16_t* r = F.proj + (size_t)(MP + 4 * b + i - 128) * NPP + SO + 512 + kvh * 64 + d; kx = bf2f(r[0]); vx = bf2f(r[128]); }
        Ks[i * SWA_KP + d] = f2bf(kx); Vt[d * SWA_VP + i] = f2bf(vx); }
    __syncthreads();
    if (wave == 0) {
        const int ti = fr >> 2, g = fr & 3, head = kvh * 4 + g, m = MP + 4 * b + ti;
        const bf16_t* qr = F.proj + (size_t)m * NPP + SO + head * 64 + gq * 8;
        const bf16x8 qf0 = *(const bf16x8*)qr, qf1 = *(const bf16x8*)(qr + 32);
        f32x4 o[4];
        swa_core(Ks, Vt, biasl, 0, qf0, qf1, 128 + ti, g, 0, F.in[24][l * 8 + head], o);
        bf16_t* op = F.mix + (size_t)m * D + 256 + head * 64 + gq * 4;
#pragma unroll
        for (int dt = 0; dt < 4; ++dt) { u32x2 w; w.x = pk2(o[dt][0], o[dt][1]); w.y = pk2(o[dt][2], o[dt][3]); *(u32x2*)(op + dt * 16) = w; }
    }
}

constexpr int LDS_BAR_OFF = 8 * 64 * 65 * 4;
constexpr int LDS_BYTES = LDS_BAR_OFF + 16;

__global__ void __launch_bounds__(512, 2) fwd_megakernel(Params p) {
    extern __shared__ __attribute__((aligned(16))) unsigned char lds[];
    cg::grid_group grid = cg::this_grid();
    PG8_LAS unsigned char* ldsl = (PG8_LAS unsigned char*)lds;
    float* ldsf = (float*)lds;
    const int G = gridDim.x;
    if (threadIdx.x < 4) ((unsigned*)(lds + LDS_BAR_OFF))[threadIdx.x] = 0u;
    __syncthreads();
    (void)xcd_barrier_post((unsigned*)(p.ws + WS_BAR), (volatile XB_LAS unsigned*)(lds + LDS_BAR_OFF));

    for (int ph = p.ph_lo; ph < p.ph_hi; ++ph) {
        Frame F;
        size_t wz = 0; asm volatile("" : "+s"(wz));
#pragma unroll
        for (int k = 0; k < 37; ++k) F.in[k] = p.in[k];
        F.out = p.out;
        unsigned char* ws = p.ws + wz;
        F.w1a = (bf16_t*)(ws + WS_W1A); F.w1b = (bf16_t*)(ws + WS_W1B); F.win = (bf16_t*)(ws + WS_WIN); F.wout = (bf16_t*)(ws + WS_WOUT); F.w2a = (bf16_t*)(ws + WS_W2A); F.w2b = (bf16_t*)(ws + WS_W2B);
        F.xf = (float*)(ws + WS_XF); F.xb = (bf16_t*)(ws + WS_XB); F.mix = F.xb; F.proj = (bf16_t*)(ws + WS_PROJ); F.h = F.proj; F.z = (float*)(ws + WS_R2); F.slab = (float*)(ws + WS_R2 + (size_t)M * D * 4);
        F.rwops = (float*)(ws + WS_RWOPS); F.rwc = (float*)(ws + WS_RWC); F.gdops = (float*)(ws + WS_GDOPS); F.gdc = (float*)(ws + WS_GDC);
        F.pq = (float*)(ws + WS_PQ); F.sst = (float*)(ws + WS_SST); F.dots = F.pq; F.li = (bf16_t*)(ws + WS_SST); F.wl = (bf16_t*)(ws + WS_WL);
        if (ph == 0) {
#ifdef PROBE_P0
            for (int rep = 0; rep < 2; ++rep) {
#else
            {
#endif
            for (size_t i = (size_t)obid() * 512 + otid(); i < (size_t)M * D / 4; i += (size_t)G * 512) {
                const f32x4 v = (i < (size_t)MP * D / 4) ? ((const f32x4*)p.in[0])[i] : ((const f32x4*)p.in[1])[i - (size_t)MP * D / 4];
                ((f32x4*)F.xf)[i] = v; u32x2 w; w.x = pk2(v[0], v[1]); w.y = pk2(v[2], v[3]); ((u32x2*)F.xb)[i] = w; }
            conv_jobs(F, -1, 0, 0x07, ldsf, obid(), G);
            conv_lora(F);
            }
        } else {
            const int l = (ph - 1) / PPL, pi = (ph - 1) % PPL;
            if (pi == 0 || pi == 12) {
                pg8::Gemm g{F.xb, pi == 0 ? F.w1a : F.w2a, M, 2 * FF, D, D}; pg8::StaticOrder S; S.init(M, 2 * FF, G, obid());
                EpiSwiGLU E{F.h};
#ifdef PROBE_G1
                for (int rep = 0; rep < (pi == 0 ? 2 : 1); ++rep)
#endif
                pg8::gemm_phase<EpiSwiGLU, pg8::StaticOrder, false>(ldsl, g, S, E, nullptr);
            } else if (pi == 1 || pi == 10 || pi == 13) {
                const bf16_t* Ap = pi == 10 ? F.mix : F.h; const bf16_t* Bp = pi == 1 ? F.w1b : (pi == 10 ? F.wout : F.w2b); const int Kd = pi == 10 ? D : FF;
                { pg8::Gemm g{Ap, Bp, MP, D, Kd, Kd}; pg8::StaticOrder S; S.init(MP, D, G, obid());
                  EpiResid E{F.xf, F.z, pi == 10 ? 1.0f : 0.5f};
#ifdef PROBE_G2
                  for (int rep = 0; rep < (pi == 1 ? 2 : 1); ++rep)
#endif
                  pg8::gemm_phase<EpiResid, pg8::StaticOrder, false>(ldsl, g, S, E, nullptr); }
                { const int nsl = Kd / 256, bid = obid(), u = bid & 7, sl = bid >> 3;
                  pg8::Gemm g{Ap + (size_t)MP * Kd + sl * 256, Bp + sl * 256, MS, D, 256, Kd}; OneUnit S{u >> 2, u & 3, sl < nsl};
                  EpiSlab E{F.slab + (size_t)sl * MS * D};
#ifdef PROBE_G2
                  for (int rep = 0; rep < (pi == 1 ? 2 : 1); ++rep)
#endif
                  pg8::gemm_phase<EpiSlab, OneUnit, false>(ldsl, g, S, E, nullptr); }
            } else if (pi == 3) {
                pg8::Gemm g{F.xb, F.win, M, NPP, D, D}; pg8::StaticOrder S; S.init(M, NPP, G, obid());
                pg8::EpiBf16<0> E{F.proj, NPP, nullptr, 0, 0};
#ifdef PROBE_G3
                for (int rep = 0; rep < 2; ++rep)
#endif
                pg8::gemm_phase<pg8::EpiBf16<0>, pg8::StaticOrder, false>(ldsl, g, S, E, nullptr);
            } else if (pi == 5) {
                pg8::Gemm g{F.li, F.wl + (size_t)l * 768 * 256, M, 768, 256, 256}; pg8::StaticOrder S; S.init(M, 768, G, obid());
                pg8::EpiF32 E{F.dots, 768, nullptr};
#ifdef PROBE_GL
                for (int rep = 0; rep < 2; ++rep)
#endif
                pg8::gemm_phase<pg8::EpiF32, pg8::StaticOrder, false>(ldsl, g, S, E, nullptr);
            } else if (pi == 2 || pi == 11 || pi == 14) {
                const int gi = pi == 2 ? 10 : (pi == 11 ? 31 : 35);
#ifdef PROBE_LN
                for (int rep = 0; rep < (pi == 2 ? 2 : 1); ++rep)
#endif
                ln_phase(F, p.in[gi] + l * D, p.in[gi + 1] + l * D, (pi == 14 && l == DEPTH - 1) ? F.out : nullptr, pi == 11 ? D / 256 : FF / 256, pi == 11 ? 1.0f : 0.5f);
                if (pi == 2) { __syncthreads(); conv_jobs(F, -1, l + 1, 0x03, ldsf, obid(), G); }
            } else if (pi == 4) {
#ifdef PROBE_P4
                for (int rep = 0; rep < 2; ++rep) {
#else
                {
#endif
                pre_a(F, l);
                copy_states(F, l);
                __syncthreads(); conv_jobs(F, -1, l + 1, 0x04, ldsf, obid(), G);
                }
            } else if (pi == 6) {
#ifdef PROBE_PRENS
                pre_b<false>(F, l);
#endif
                pre_b<true>(F, l);
#ifdef PROBE_PRE
                pre_b<true>(F, l);
#endif
            } else if (pi == 7) {
                scan_pass1(F, ldsf);
#ifdef PROBE_S1
                scan_pass1(F, ldsf);
#endif
            } else if (pi == 8) {
#ifdef PROBE_S2
                for (int rep = 0; rep < 2; ++rep) {
#else
                {
#endif
                const int ncb = 32;
                if (obid() < ncb) chain_prop(F, l, obid(), ldsf);
                else {
                    const int vb = obid() - ncb, nvb = G - ncb;
#ifdef PROBE_SWAP
                    for (int it = vb; it < 256; it += nvb) swa_prompt_item(F, l, it, lds);
#endif
                    for (int it = vb; it < 256; it += nvb) swa_prompt_item(F, l, it, lds);
                    for (int it = vb; it < 256; it += nvb) swa_sample_item(F, l, it, lds);
                    __syncthreads();
                    scan_sample(F, l, vb, nvb, ldsf);
#ifdef PROBE_SSMP
                    scan_sample(F, l, vb, nvb, ldsf);
#endif
                    __syncthreads();
                    conv_jobs(F, l, -1, 0x38, ldsf, vb, nvb);
                }
                __syncthreads();
                }
            } else if (pi == 9) {
                scan_pass3(F, l, ldsf);
#ifdef PROBE_S3
                scan_pass3(F, l, ldsf);
#endif
            }
        }
        if (ph + 1 < p.ph_hi) { if (ph == p.ph_lo) grid.sync(); else { XcdBarrier xb; xb.bar = (unsigned*)(p.ws + WS_BAR); xb.x = xb_xcc_id(); xb.st = (volatile XB_LAS unsigned*)(lds + LDS_BAR_OFF); xcd_barrier(xb); } }
#ifdef PROBE_SYNC
        if (ph + 1 < p.ph_hi) { XcdBarrier xb; xb.bar = (unsigned*)(p.ws + WS_BAR); xb.x = xb_xcc_id(); xb.st = (volatile XB_LAS unsigned*)(lds + LDS_BAR_OFF); xcd_barrier(xb); }
#endif
    }
}
}

extern "C" void kernel_launch(void* const* d_in, const int* in_sizes, int n_in, void* d_out, int out_size, void* d_ws, size_t ws_size, hipStream_t stream) {
    static int grid = 0;
    if (grid == 0) {
        int dev = 0, cus = 0, per_cu = 0;
        hipGetDevice(&dev);
        hipDeviceGetAttribute(&cus, hipDeviceAttributeMultiprocessorCount, dev);
        hipFuncSetAttribute((const void*)mk::fwd_megakernel, hipFuncAttributeMaxDynamicSharedMemorySize, mk::LDS_BYTES);
        hipOccupancyMaxActiveBlocksPerMultiprocessor(&per_cu, (const void*)mk::fwd_megakernel, 512, mk::LDS_BYTES);
        (void)hipGetLastError();
        if (per_cu < 1) per_cu = 1;
        if (per_cu > 1) per_cu = 1;
        grid = cus * per_cu;
        if (n_in != 37 || ws_size < mk::WS_END || (size_t)out_size != mk::O_END)
            fprintf(stderr, "kernel_launch: unexpected shapes: n_in %d ws %zu (need %zu) out %d (expect %zu)\n", n_in, ws_size, (size_t)mk::WS_END, out_size, (size_t)mk::O_END);
    }
    mk::Params p{};
    for (int i = 0; i < 37; ++i) p.in[i] = (const float*)d_in[i];
    p.out = (float*)d_out; p.ws = (unsigned char*)d_ws; p.ph_lo = 0; p.ph_hi = mk::NPH;
    (void)hipMemsetAsync((unsigned char*)d_ws + mk::WS_BAR, 0, 16384, stream);
    void* args[] = {&p};
    hipError_t e = hipLaunchCooperativeKernel((const void*)mk::fwd_megakernel, dim3(grid), dim3(512), args, mk::LDS_BYTES, stream);
    if (e != hipSuccess) fprintf(stderr, "cooperative launch failed: %s (grid %d)\n", hipGetErrorString(e), grid);
}
```
